# Optimizing an MI355X kernel written in HIP

```python
import math
import jax, jax.numpy as jnp
from jax import lax
import numpy as np

D_MODEL = 1024
BATCH = 8
SEQ = 2048
DEPTH = 2

GRID_W = 64
HEAD_DIM = 64
NA_HEADS = D_MODEL // 128
NA_WIDTH = NA_HEADS * HEAD_DIM
NA_KH_MAX = 8
NA_KW = 16
GQA_HEADS = D_MODEL // 128
GQA_KV_HEADS = max(1, GQA_HEADS // 4)
GQA_WIDTH = GQA_HEADS * HEAD_DIM
GQA_KV_WIDTH = GQA_KV_HEADS * HEAD_DIM
Q_BLOCK = 128
ROPE_THETA = 10000.0
ROPE_AXIS_DIM = HEAD_DIM // 2
SG_WIDTH = D_MODEL // 2
SG_GROUPS = SG_WIDTH // HEAD_DIM
SG_CHUNK = 128
N_BRANCH = 3
LN_EPS = 1e-5
RMS_EPS = 1e-6
DEEPNORM_ALPHA = (2.0 * DEPTH) ** 0.25
DEEPNORM_BETA = (8.0 * DEPTH) ** -0.25
IN_SPLITS = (NA_WIDTH, NA_WIDTH, NA_WIDTH, NA_WIDTH,
             GQA_WIDTH, GQA_KV_WIDTH, GQA_KV_WIDTH, GQA_WIDTH,
             SG_WIDTH, SG_WIDTH, SG_WIDTH,
             N_BRANCH * D_MODEL)
IN_WIDTH = 4 * NA_WIDTH + 2 * GQA_WIDTH + 2 * GQA_KV_WIDTH + 3 * SG_WIDTH + N_BRANCH * D_MODEL

kernel_name = "hybrid_na_gqa_sgmlp_deepnorm_encoder"


def _split_points():
    pts, acc = [], 0
    for w in IN_SPLITS[:-1]:
        acc += w
        pts.append(acc)
    return pts


def layer_norm(x, g, b):
    xf = x.astype(jnp.float32)
    mu = jnp.mean(xf, axis=-1, keepdims=True)
    var = jnp.mean(jnp.square(xf - mu), axis=-1, keepdims=True)
    return ((xf - mu) * lax.rsqrt(var + LN_EPS)).astype(x.dtype) * g + b


def rms_norm(x, g):
    xf = x.astype(jnp.float32)
    ms = jnp.mean(jnp.square(xf), axis=-1, keepdims=True)
    return (xf * lax.rsqrt(ms + RMS_EPS)).astype(x.dtype) * g


def axial_rope_tables(s):
    t = jnp.arange(s)
    row = (t // GRID_W).astype(jnp.float32)
    col = (t % GRID_W).astype(jnp.float32)
    freqs = ROPE_THETA ** (-jnp.arange(0, ROPE_AXIS_DIM, 2, dtype=jnp.float32) / ROPE_AXIS_DIM)
    ang = jnp.concatenate([row[:, None] * freqs, col[:, None] * freqs], axis=-1)
    return jnp.cos(ang), jnp.sin(ang)


def apply_rope(x, cos, sin):
    xf = x.astype(jnp.float32).reshape(*x.shape[:-1], HEAD_DIM // 2, 2)
    x0, x1 = xf[..., 0], xf[..., 1]
    c = cos[None, :, None, :]
    s = sin[None, :, None, :]
    out = jnp.stack([x0 * c - x1 * s, x0 * s + x1 * c], axis=-1)
    return out.reshape(x.shape).astype(x.dtype)


def neighbourhood_attention(q, k, v, rpb):
    b, s, h, dh = q.shape
    rows = s // GRID_W
    kh = min(NA_KH_MAX, rows)
    r = jnp.arange(rows)
    row_start = jnp.clip(r - kh // 2, 0, rows - kh)
    key_rows = row_start[:, None] + jnp.arange(kh)[None, :]
    c = jnp.arange(GRID_W)
    col_start = jnp.clip(c - NA_KW // 2, 0, GRID_W - NA_KW)
    col_valid = (c[None, :] >= col_start[:, None]) & (c[None, :] < col_start[:, None] + NA_KW)
    qg = q.reshape(b, rows, GRID_W, h, dh)
    kg = k.reshape(b, rows, GRID_W, h, dh)[:, key_rows]
    vg = v.reshape(b, rows, GRID_W, h, dh)[:, key_rows]
    scores = jnp.einsum('brqhd,brjkhd->bhrqjk', qg, kg).astype(jnp.float32) * (dh ** -0.5)
    row_off = key_rows - r[:, None] + (NA_KH_MAX - 1)
    col_off = jnp.clip(c[None, :] - c[:, None] + (NA_KW - 1), 0, 2 * NA_KW - 2)
    bias = rpb[:, row_off[:, None, :, None], col_off[None, :, None, :]]
    scores = scores + bias.astype(jnp.float32)
    scores = jnp.where(col_valid[:, None, :], scores, jnp.float32(-1e30))
    shp = scores.shape
    p = jax.nn.softmax(scores.reshape(b, h, rows, GRID_W, kh * GRID_W), axis=-1)
    p = p.reshape(shp).astype(v.dtype)
    out = jnp.einsum('bhrqjk,brjkhd->brqhd', p, vg)
    return out.reshape(b, s, h * dh)


def gqa_attention(q, k, v):
    b, s, hq, dh = q.shape
    hkv = k.shape[2]
    grp = hq // hkv
    nblk = s // Q_BLOCK
    qb = q.reshape(b, nblk, Q_BLOCK, hkv, grp, dh).transpose(1, 0, 2, 3, 4, 5)
    scale = dh ** -0.5

    def block(qi):
        sc = jnp.einsum('bqkgd,bskd->bkgqs', qi, k).astype(jnp.float32) * scale
        p = jax.nn.softmax(sc, axis=-1).astype(v.dtype)
        return jnp.einsum('bkgqs,bskd->bqkgd', p, v)

    out = lax.map(block, qb)
    return out.transpose(1, 0, 2, 3, 4, 5).reshape(b, s, hq * dh)


def spatial_gating(u, v, ln_g, ln_b, w_s, b_s):
    b, s, wc = u.shape
    vn = layer_norm(v, ln_g, ln_b)
    vc = vn.reshape(b, s // SG_CHUNK, SG_CHUNK, SG_GROUPS, wc // SG_GROUPS)
    mixed = jnp.einsum('gmn,bcngd->bcmgd', w_s, vc) + b_s.T[None, None, :, :, None]
    return u * mixed.reshape(b, s, wc)


def hybrid_layer(x, w_in, b_in, na_rpb, q_norm_g, k_norm_g, sg_ln_g, sg_ln_b, sg_w, sg_b,
                 w_br_a, w_br_b, w_br_c, w_out, b_out, ln_g, ln_b, rope_cos, rope_sin):
    b, s, d = x.shape
    hcat = x @ w_in + b_in
    (na_q, na_k, na_v, na_z, gq_q, gq_k, gq_v, gq_z,
     sg_u, sg_v, sg_z, gates) = jnp.split(hcat, _split_points(), axis=-1)

    y_a = neighbourhood_attention(na_q.reshape(b, s, NA_HEADS, HEAD_DIM),
                                  na_k.reshape(b, s, NA_HEADS, HEAD_DIM),
                                  na_v.reshape(b, s, NA_HEADS, HEAD_DIM), na_rpb)
    p_a = (y_a * jax.nn.silu(na_z)) @ w_br_a

    q = apply_rope(rms_norm(gq_q.reshape(b, s, GQA_HEADS, HEAD_DIM), q_norm_g), rope_cos, rope_sin)
    k = apply_rope(rms_norm(gq_k.reshape(b, s, GQA_KV_HEADS, HEAD_DIM), k_norm_g), rope_cos, rope_sin)
    y_b = gqa_attention(q, k, gq_v.reshape(b, s, GQA_KV_HEADS, HEAD_DIM))
    p_b = (y_b * jax.nn.silu(gq_z)) @ w_br_b

    y_c = spatial_gating(sg_u, sg_v, sg_ln_g, sg_ln_b, sg_w, sg_b)
    p_c = (y_c * jax.nn.silu(sg_z)) @ w_br_c

    g = jax.nn.sigmoid(gates.reshape(b, s, N_BRANCH, d))
    merged = g[:, :, 0] * p_a + g[:, :, 1] * p_b + g[:, :, 2] * p_c
    sub = merged @ w_out + b_out
    return layer_norm(DEEPNORM_ALPHA * x + sub, ln_g, ln_b)


def setup_inputs(seed: int = 0) -> dict:
    key = jax.random.key(seed)
    ks = jax.random.split(key, 20)
    L, D = DEPTH, D_MODEL

    def nrm(k, shape, scale):
        return jax.random.normal(k, shape, jnp.float32) * scale

    return {
        "x": nrm(ks[0], (BATCH, SEQ, D), 1.0),
        "ln_in_g": 1.0 + nrm(ks[1], (D,), 0.02),
        "ln_in_b": nrm(ks[2], (D,), 0.02),
        "w_in": nrm(ks[3], (L, D, IN_WIDTH), D ** -0.5),
        "b_in": nrm(ks[4], (L, IN_WIDTH), 0.02),
        "na_rpb": nrm(ks[5], (L, NA_HEADS, 2 * NA_KH_MAX - 1, 2 * NA_KW - 1), 0.1),
        "q_norm_g": 1.0 + nrm(ks[6], (L, HEAD_DIM), 0.02),
        "k_norm_g": 1.0 + nrm(ks[7], (L, HEAD_DIM), 0.02),
        "sg_ln_g": 1.0 + nrm(ks[8], (L, SG_WIDTH), 0.02),
        "sg_ln_b": nrm(ks[9], (L, SG_WIDTH), 0.02),
        "sg_w": nrm(ks[10], (L, SG_GROUPS, SG_CHUNK, SG_CHUNK), SG_CHUNK ** -0.5),
        "sg_b": 1.0 + nrm(ks[11], (L, SG_GROUPS, SG_CHUNK), 0.02),
        "w_br_a": nrm(ks[12], (L, NA_WIDTH, D), NA_WIDTH ** -0.5),
        "w_br_b": nrm(ks[13], (L, GQA_WIDTH, D), GQA_WIDTH ** -0.5),
        "w_br_c": nrm(ks[14], (L, SG_WIDTH, D), SG_WIDTH ** -0.5),
        "w_out": nrm(ks[15], (L, D, D), (D ** -0.5) * DEEPNORM_BETA),
        "b_out": nrm(ks[16], (L, D), 0.02),
        "ln_post_g": 1.0 + nrm(ks[17], (L, D), 0.02),
        "ln_post_b": nrm(ks[18], (L, D), 0.02),
    }


def reference(x, ln_in_g, ln_in_b, w_in, b_in, na_rpb, q_norm_g, k_norm_g, sg_ln_g, sg_ln_b,
              sg_w, sg_b, w_br_a, w_br_b, w_br_c, w_out, b_out, ln_post_g, ln_post_b):
    s = x.shape[1]
    rope_cos, rope_sin = axial_rope_tables(s)
    h = layer_norm(x, ln_in_g, ln_in_b)
    for l in range(DEPTH):
        h = hybrid_layer(h, w_in[l], b_in[l], na_rpb[l], q_norm_g[l], k_norm_g[l],
                         sg_ln_g[l], sg_ln_b[l], sg_w[l], sg_b[l],
                         w_br_a[l], w_br_b[l], w_br_c[l], w_out[l], b_out[l],
                         ln_post_g[l], ln_post_b[l], rope_cos, rope_sin)
    return h
```

```cpp
#include <hip/hip_runtime.h>
#include <hip/hip_cooperative_groups.h>
#include <cstdio>
#include <cstdint>
namespace cg = cooperative_groups;
namespace pg8 {
#define PG8_LAS __attribute__((address_space(3)))
typedef unsigned short bf16_t;
typedef short bf16x8 __attribute__((ext_vector_type(8)));
typedef float f32x4 __attribute__((ext_vector_type(4)));
typedef unsigned u32x4 __attribute__((ext_vector_type(4)));
constexpr int BM = 256, BK = 64, HALF = 128, HTB = HALF * BK * 2  , STAGE_BYTES = 8 * HTB, NXCD = 8, WGM = 8;

__host__ __device__ __forceinline__ int lds_byte(int r, int c) { const int st = (r >> 4) * 2 + (c >> 5), rr = r & 15, cc = c & 31, ob = rr * 64 + cc * 2; return st * 1024 + (ob ^ (((ob >> 9) & 1) << 5)); }
__host__ __device__ __forceinline__ void stage_rc(int b, int& R, int& C) { const int st = b / 1024, sb = b % 1024, swz = sb ^ (((sb >> 9) & 1) << 5); R = (st >> 1) * 16 + swz / 64; C = (st & 1) * 32 + (swz % 64) / 2; }
__host__ __device__ __forceinline__ int perm32(int rho) { const int n = rho >> 4, i = rho & 15; return 8 * (i >> 2) + 4 * n + (i & 3); }

struct Unit { int pm, pn; };
struct Gemm { const bf16_t* A; const bf16_t* Bt; int M, N, K, lda, ldb; };

struct StaticOrder {
    int nM, nN, nwg, G, c;
    __host__ __device__ void init(int M, int N, int G_, int c_) { nM = M / BM; nN = N / BM; nwg = nM * nN; G = G_; c = c_; }
    __host__ __device__ bool next(int i, Unit& u) const {
        const long L = (long)i * G + c; if (L >= nwg) return false;
        int wgid = (int)L; { const int q = nwg / NXCD, r = nwg % NXCD, xcd = wgid % NXCD, off = wgid / NXCD; wgid = (xcd < r ? xcd * (q + 1) : r * (q + 1) + (xcd - r) * q) + off; }
        const int nig = WGM * nN, gid = wgid / nig, fm = gid * WGM, gsz = (nM - fm) < WGM ? (nM - fm) : WGM;
        u.pm = fm + ((wgid % nig) % gsz); u.pn = (wgid % nig) / gsz; return true;
    }
    __device__ __forceinline__ void a_ready(const Unit&) const {}
    __device__ __forceinline__ void done(const Unit&) const {}
};

__device__ __forceinline__ unsigned cvt_pk_bf16(float lo, float hi) { unsigned r; asm volatile("v_cvt_pk_bf16_f32 %0, %1, %2" : "=v"(r) : "v"(lo), "v"(hi)); return r; }
__device__ __forceinline__ float bf_lo(unsigned w) { return __uint_as_float(w << 16); }
__device__ __forceinline__ float bf_hi(unsigned w) { return __uint_as_float(w & 0xffff0000u); }
constexpr float LOG2E = 1.4426950408889634f;
constexpr float C2 = 0.125f * LOG2E;
__device__ __forceinline__ float sigmoid_f(float x) { return __builtin_amdgcn_rcpf(1.0f + __builtin_amdgcn_exp2f(-x * LOG2E)); }

struct EpiIn {
    static constexpr bool PERM = true, AFTER_DRAIN = false, MIDHOOK = false;
    bf16_t* QU; bf16_t* REST; bf16_t* G; const float* biasv; const float* qg; const float* kg; int vt0;
    __device__ __forceinline__ void operator()(const f32x4 (&acc)[2][2][4][2], const Unit& u, int wr, int wc, int fr, int fq) const {
        const int vt = u.pn + vt0;
        const int vc0 = vt * 256 + wc * 64 + fq * 8;
        bf16_t* dst; int pitch, dcol;
        if (vt < 6) { dst = QU; pitch = 1536; dcol = vc0; } else if (vt < 19) { dst = REST; pitch = 3328; dcol = vc0 - 1536; } else { dst = G; pitch = 3072; dcol = vc0 - 4864; }
        int type = 0; float sc = 1.f; const float* ng = qg;
        if (vt < 2) sc = C2;
        else if (vt < 4) { type = 3; sc = C2; }
        else if (vt == 10 || vt == 11 || vt == 13 || vt == 14 || vt == 17 || vt == 18) type = 1;
        else if (vt == 12) { if (wc < 2) { type = 3; ng = kg; } }
        else if (vt >= 19) type = 2;
        f32x4 bv[2][2];
#pragma unroll
        for (int bj = 0; bj < 2; ++bj)
#pragma unroll
            for (int n = 0; n < 2; ++n) bv[bj][n] = *(const f32x4*)(biasv + vc0 + bj * 32 + 4 * n);
        const int row0 = u.pm * BM + wr * 64 + fr;
        if (type == 3) {
#pragma unroll
            for (int ai = 0; ai < 2; ++ai)
#pragma unroll
                for (int m = 0; m < 4; ++m) {
                    asm volatile("" ::: "memory");
                    int fqo = fq; asm volatile("" : "+v"(fqo));
                    const float* bp = biasv + vt * 256 + wc * 64 + fqo * 8; const float* gp = ng + fqo * 8;
                    const int row = row0 + ai * HALF + m * 16; const int s = row & 2047; const float pr = (float)(s >> 6), pc = (float)(s & 63);
                    float ss = 0.f;
#pragma unroll
                    for (int bj = 0; bj < 2; ++bj)
#pragma unroll
                        for (int n = 0; n < 2; ++n) { const f32x4 v = acc[ai][bj][m][n] + *(const f32x4*)(bp + bj * 32 + 4 * n); ss += (v[0] * v[0] + v[1] * v[1]) + (v[2] * v[2] + v[3] * v[3]); }
                    ss += __shfl_xor(ss, 16); ss += __shfl_xor(ss, 32);
                    const float rs = __builtin_amdgcn_rsqf(ss * (1.0f / 64.0f) + 1e-6f);
                    bf16_t* rowp = dst + (size_t)row * pitch + dcol;
#pragma unroll
                    for (int bj = 0; bj < 2; ++bj) { const float pos = bj ? pc : pr; u32x4 w;
#pragma unroll
                        for (int n = 0; n < 2; ++n) { const f32x4 v = (acc[ai][bj][m][n] + *(const f32x4*)(bp + bj * 32 + 4 * n)) * rs * *(const f32x4*)(gp + bj * 32 + 4 * n);
#pragma unroll
                            for (int h = 0; h < 2; ++h) { const float fr_ = __builtin_amdgcn_exp2f(-(float)(4 * fqo + 2 * n + h) * 0.8304820237218407f) * 0.15915494309189535f;
                                const float ang = pos * fr_; const float c = __builtin_amdgcn_cosf(ang), sn = __builtin_amdgcn_sinf(ang);
                                w[2 * n + h] = cvt_pk_bf16((v[2 * h] * c - v[2 * h + 1] * sn) * sc, (v[2 * h] * sn + v[2 * h + 1] * c) * sc); } }
                        *(u32x4*)(rowp + bj * 32) = w; }
                    __builtin_amdgcn_sched_barrier(0);
                }
        } else {
#pragma unroll
            for (int ai = 0; ai < 2; ++ai)
#pragma unroll
                for (int m = 0; m < 4; ++m) { bf16_t* rowp = dst + (size_t)(row0 + ai * HALF + m * 16) * pitch + dcol;
#pragma unroll
                    for (int bj = 0; bj < 2; ++bj) { f32x4 v0 = acc[ai][bj][m][0] + bv[bj][0], v1 = acc[ai][bj][m][1] + bv[bj][1];
                        if (type == 1) {
#pragma unroll
                            for (int e = 0; e < 4; ++e) { v0[e] *= sigmoid_f(v0[e]); v1[e] *= sigmoid_f(v1[e]); } }
                        else if (type == 2) {
#pragma unroll
                            for (int e = 0; e < 4; ++e) { v0[e] = fmaxf(sigmoid_f(v0[e]), 1e-30f); v1[e] = fmaxf(sigmoid_f(v1[e]), 1e-30f); } }
                        else { v0 = v0 * sc; v1 = v1 * sc; }
                        u32x4 w; w.x = cvt_pk_bf16(v0[0], v0[1]); w.y = cvt_pk_bf16(v0[2], v0[3]); w.z = cvt_pk_bf16(v1[0], v1[1]); w.w = cvt_pk_bf16(v1[2], v1[3]);
                        *(u32x4*)(rowp + bj * 32) = w; } }
        }
    }
};

struct EpiMerge {
    static constexpr bool PERM = true, AFTER_DRAIN = false, MIDHOOK = true;
    const bf16_t* G; bf16_t* O;
    __device__ __forceinline__ void mid(f32x4 (&acc)[2][2][4][2], const Unit& u, int seg, int wr, int wc, int fr, int fq) const {
        const int row0 = u.pm * BM + wr * 64 + fr, col0 = u.pn * BM + wc * 32 + 8 * fq;
        const bf16_t* gp = G + (size_t)row0 * 3072 + (seg - 1) * 1024 + col0;
#pragma unroll
        for (int ai = 0; ai < 2; ++ai)
#pragma unroll
            for (int m = 0; m < 4; ++m)
#pragma unroll
                for (int bj = 0; bj < 2; ++bj) { const bf16_t* p = gp + (size_t)(ai * HALF + m * 16) * 3072 + bj * HALF;
                    const u32x4 ga = *(const u32x4*)p, gb = *(const u32x4*)(p + 1024);
#pragma unroll
                    for (int e = 0; e < 2; ++e) {
                        acc[ai][bj][m][0][2 * e] *= bf_lo(ga[e]) * __builtin_amdgcn_rcpf(bf_lo(gb[e])); acc[ai][bj][m][0][2 * e + 1] *= bf_hi(ga[e]) * __builtin_amdgcn_rcpf(bf_hi(gb[e]));
                        acc[ai][bj][m][1][2 * e] *= bf_lo(ga[2 + e]) * __builtin_amdgcn_rcpf(bf_lo(gb[2 + e])); acc[ai][bj][m][1][2 * e + 1] *= bf_hi(ga[2 + e]) * __builtin_amdgcn_rcpf(bf_hi(gb[2 + e])); } }
    }
    __device__ __forceinline__ void operator()(const f32x4 (&acc)[2][2][4][2], const Unit& u, int wr, int wc, int fr, int fq) const {
        const int row0 = u.pm * BM + wr * 64 + fr, col0 = u.pn * BM + wc * 32 + 8 * fq;
#pragma unroll
        for (int ai = 0; ai < 2; ++ai)
#pragma unroll
            for (int m = 0; m < 4; ++m)
#pragma unroll
                for (int bj = 0; bj < 2; ++bj) { const size_t r = (size_t)(row0 + ai * HALF + m * 16);
                    const u32x4 g2 = *(const u32x4*)(G + r * 3072 + 2048 + col0 + bj * HALF);
                    const f32x4 a0 = acc[ai][bj][m][0], a1 = acc[ai][bj][m][1]; u32x4 w;
                    w.x = cvt_pk_bf16(a0[0] * bf_lo(g2.x), a0[1] * bf_hi(g2.x)); w.y = cvt_pk_bf16(a0[2] * bf_lo(g2.y), a0[3] * bf_hi(g2.y));
                    w.z = cvt_pk_bf16(a1[0] * bf_lo(g2.z), a1[1] * bf_hi(g2.z)); w.w = cvt_pk_bf16(a1[2] * bf_lo(g2.w), a1[3] * bf_hi(g2.w));
                    *(u32x4*)(O + r * 1024 + col0 + bj * HALF) = w; }
    }
};

struct EpiOut {
    static constexpr bool PERM = false, AFTER_DRAIN = false, MIDHOOK = false;
    float* H; const float* bias; float alpha;
    __device__ __forceinline__ void operator()(const f32x4 (&acc)[2][2][4][2], const Unit& u, int wr, int wc, int fr, int fq) const {
        const int row0 = u.pm * BM + wr * 64 + fr, col0 = u.pn * BM + wc * 32 + 4 * fq;
        f32x4 bv[2][2];
#pragma unroll
        for (int bj = 0; bj < 2; ++bj)
#pragma unroll
            for (int n = 0; n < 2; ++n) bv[bj][n] = *(const f32x4*)(bias + col0 + bj * HALF + n * 16);
#pragma unroll
        for (int ai = 0; ai < 2; ++ai)
#pragma unroll
            for (int m = 0; m < 4; ++m) { float* rowp = H + (size_t)(row0 + ai * HALF + m * 16) * 1024 + col0;
#pragma unroll
                for (int bj = 0; bj < 2; ++bj)
#pragma unroll
                    for (int n = 0; n < 2; ++n) { float* p = rowp + bj * HALF + n * 16; const f32x4 hv = *(const f32x4*)p; *(f32x4*)p = hv * alpha + acc[ai][bj][m][n] + bv[bj][n]; } }
    }
};
template <class Epi, class Sched, bool ALIGN_EPI = false, bool SP2 = false>
__device__ __forceinline__ void gemm_phase(PG8_LAS unsigned char* lds, const Gemm g, const Sched& S, const Epi& E) {
    int tid_ = threadIdx.x; asm volatile("" : "+v"(tid_));
    const int tid = tid_, wid = __builtin_amdgcn_readfirstlane(tid >> 6), lane = tid & 63, wr = wid >> 2, wc = wid & 3, fr = lane & 15, fq = lane >> 4;
    const int K = g.K, nt = K / BK;
    unsigned voffA[2], voffB[2];
#pragma unroll
    for (int i = 0; i < 2; ++i) { int R, C; stage_rc(tid * 16 + i * 8192, R, C); const int Rb = Epi::PERM ? ((R & ~31) + perm32(R & 31)) : R;
        voffA[i] = (unsigned)(R * g.lda + C) * 2u; voffB[i] = (unsigned)(Rb * g.ldb + C) * 2u; }
    const size_t kstep = (size_t)(BK * 2);
    const size_t hstepA = (size_t)HALF * g.lda * 2, hstepB = (size_t)HALF * g.ldb * 2;
    const size_t tstepA = 2 * hstepA, tstepB = 2 * hstepB;
    const unsigned ldsw = (unsigned)wid * 1024u;
    const int aoff = lds_byte(wr * 64 + fr, fq * 8), boff = lds_byte(wc * 32 + fr, fq * 8);
#define PG8_SA(b, h) (((b) * 2 + (h)) * HTB)
#define PG8_SB(b, h) ((4 + (b) * 2 + (h)) * HTB)
#define PG8_STAGE(bufoff, gbase, voff) do { _Pragma("unroll") for (int _i = 0; _i < 2; ++_i) \
        __builtin_amdgcn_global_load_lds((const unsigned*)((const char*)(gbase) + (voff)[_i]), (PG8_LAS unsigned*)(lds + (bufoff) + ldsw + _i * 8192), 16, 0, 0); } while (0)
#define PG8_LDA(dst, b, h) do { _Pragma("unroll") for (int m = 0; m < 4; ++m) _Pragma("unroll") for (int k = 0; k < 2; ++k) dst[m][k] = *(const PG8_LAS bf16x8*)(lds + PG8_SA(b, h) + aoff + m * 2048 + k * 1024); } while (0)
#define PG8_LDB(dst, b, h) do { _Pragma("unroll") for (int n = 0; n < 2; ++n) _Pragma("unroll") for (int k = 0; k < 2; ++k) dst[n][k] = *(const PG8_LAS bf16x8*)(lds + PG8_SB(b, h) + boff + n * 2048 + k * 1024); } while (0)
#define PG8_MMA(ai, bj, At, Bt) do { __builtin_amdgcn_s_setprio(1); _Pragma("unroll") for (int m = 0; m < 4; ++m) _Pragma("unroll") for (int n = 0; n < 2; ++n) _Pragma("unroll") for (int k = 0; k < 2; ++k) \
        acc[ai][bj][m][n] = __builtin_amdgcn_mfma_f32_16x16x32_bf16(Bt[n][k], At[m][k], acc[ai][bj][m][n], 0, 0, 0); __builtin_amdgcn_s_setprio(0); } while (0)
#define PG8_WAIT_V(n) asm volatile("s_waitcnt vmcnt(" #n ")" ::: "memory")
#define PG8_WAIT_L(n) asm volatile("s_waitcnt lgkmcnt(" #n ")" ::: "memory")
#define PG8_BAR __builtin_amdgcn_s_barrier()
#define PG8_SCHED __builtin_amdgcn_sched_barrier(0)
    Unit cur, nxt; int ui = 0;
    if (!S.next(0, cur)) return;
    f32x4 acc[2][2][4][2];
#pragma unroll
    for (int a = 0; a < 2; ++a)
#pragma unroll
        for (int b = 0; b < 2; ++b)
#pragma unroll
            for (int m = 0; m < 4; ++m)
#pragma unroll
                for (int n = 0; n < 2; ++n) acc[a][b][m][n] = (f32x4){0.f, 0.f, 0.f, 0.f};
    bf16x8 At[4][2], B0[2][2], B1[2][2];
    const char* cA = (const char*)g.A + (size_t)cur.pm * tstepA; const char* cB = (const char*)g.Bt + (size_t)cur.pn * tstepB;
    S.a_ready(cur);
    if constexpr (SP2) {
        PG8_STAGE(PG8_SB(0, 0), cB, voffB); PG8_STAGE(PG8_SB(0, 1), cB + hstepB, voffB); PG8_STAGE(PG8_SA(0, 0), cA, voffA); PG8_STAGE(PG8_SA(0, 1), cA + hstepA, voffA);
        if (wr == 1) PG8_BAR;
        PG8_WAIT_V(2); PG8_BAR;
        PG8_STAGE(PG8_SB(1, 0), cB + kstep, voffB); PG8_STAGE(PG8_SA(1, 0), cA + kstep, voffA); PG8_STAGE(PG8_SB(1, 1), cB + hstepB + kstep, voffB);
        PG8_WAIT_V(6); PG8_BAR;
    } else {
        PG8_STAGE(PG8_SB(0, 0), cB, voffB); PG8_STAGE(PG8_SA(0, 0), cA, voffA); PG8_STAGE(PG8_SB(0, 1), cB + hstepB, voffB); PG8_STAGE(PG8_SA(0, 1), cA + hstepA, voffA);
        if (wr == 1) PG8_BAR;
        PG8_WAIT_V(4); PG8_BAR;
        PG8_STAGE(PG8_SB(1, 0), cB + kstep, voffB); PG8_STAGE(PG8_SA(1, 0), cA + kstep, voffA); PG8_STAGE(PG8_SB(1, 1), cB + hstepB + kstep, voffB);
        PG8_WAIT_V(6); PG8_BAR;
    }
    for (;;) {
        const bool has_next = S.next(ui + 1, nxt);
        const char* nA = has_next ? (const char*)g.A + (size_t)nxt.pm * tstepA : cA; const char* nB = has_next ? (const char*)g.Bt + (size_t)nxt.pn * tstepB : cB;
        for (int t = 0; t < nt; t += 2) {
            const bool last = (t == nt - 2);
            const char* a1 = cA + (size_t)(t + 1) * kstep;
            const char* a2 = last ? nA : cA + (size_t)(t + 2) * kstep; const char* b2 = last ? nB : cB + (size_t)(t + 2) * kstep;
            const char* a3 = a2 + kstep; const char* b3 = b2 + kstep;
            if (last && has_next) S.a_ready(nxt);
            if constexpr (Epi::MIDHOOK) { if (t == 8 || t == 16) E.mid(acc, cur, t >> 3, wr, wc, fr, fq); }
            if constexpr (SP2) {
            PG8_LDB(B0, 0, 0); PG8_LDB(B1, 0, 1); PG8_SCHED; PG8_LDA(At, 0, 0); PG8_STAGE(PG8_SA(1, 1), a1 + hstepA, voffA);
            PG8_WAIT_V(8); PG8_WAIT_L(0); PG8_BAR; PG8_MMA(0, 0, At, B0); PG8_MMA(0, 1, At, B1); PG8_BAR; PG8_SCHED;
            PG8_LDA(At, 0, 1); PG8_STAGE(PG8_SB(0, 0), b2, voffB); PG8_STAGE(PG8_SB(0, 1), b2 + hstepB, voffB); PG8_STAGE(PG8_SA(0, 0), a2, voffA);
            PG8_WAIT_V(8); PG8_WAIT_L(0); PG8_BAR; PG8_MMA(1, 0, At, B0); PG8_MMA(1, 1, At, B1); PG8_BAR; PG8_SCHED;
            PG8_LDB(B0, 1, 0); PG8_LDB(B1, 1, 1); PG8_SCHED; PG8_LDA(At, 1, 0); PG8_STAGE(PG8_SA(0, 1), a2 + hstepA, voffA);
            PG8_WAIT_V(8); PG8_WAIT_L(0); PG8_BAR; PG8_MMA(0, 0, At, B0); PG8_MMA(0, 1, At, B1); PG8_BAR; PG8_SCHED;
            PG8_LDA(At, 1, 1); PG8_STAGE(PG8_SB(1, 0), b3, voffB); PG8_STAGE(PG8_SB(1, 1), b3 + hstepB, voffB); PG8_STAGE(PG8_SA(1, 0), a3, voffA);
            PG8_WAIT_V(8); PG8_WAIT_L(0); PG8_BAR; PG8_MMA(1, 0, At, B0); PG8_MMA(1, 1, At, B1); PG8_BAR; PG8_SCHED;
            } else {
            PG8_LDB(B0, 0, 0); PG8_SCHED; PG8_LDA(At, 0, 0); PG8_STAGE(PG8_SA(1, 1), a1 + hstepA, voffA);
            PG8_WAIT_L(8); PG8_BAR; PG8_WAIT_L(0); PG8_MMA(0, 0, At, B0); PG8_BAR; PG8_SCHED;
            PG8_LDB(B1, 0, 1); PG8_STAGE(PG8_SB(0, 0), b2, voffB);
            PG8_BAR; PG8_WAIT_L(0); PG8_MMA(0, 1, At, B1); PG8_BAR;
            PG8_LDA(At, 0, 1); PG8_STAGE(PG8_SA(0, 0), a2, voffA);
            PG8_BAR; PG8_WAIT_L(0); PG8_MMA(1, 0, At, B0); PG8_BAR; PG8_SCHED;
            PG8_STAGE(PG8_SB(0, 1), b2 + hstepB, voffB);
            PG8_WAIT_V(6); PG8_BAR; PG8_MMA(1, 1, At, B1); PG8_BAR;
            PG8_LDB(B0, 1, 0); PG8_SCHED; PG8_LDA(At, 1, 0); PG8_STAGE(PG8_SA(0, 1), a2 + hstepA, voffA);
            PG8_WAIT_L(8); PG8_BAR; PG8_WAIT_L(0); PG8_MMA(0, 0, At, B0); PG8_BAR; PG8_SCHED;
            PG8_LDB(B1, 1, 1); PG8_STAGE(PG8_SB(1, 0), b3, voffB);
            PG8_BAR; PG8_WAIT_L(0); PG8_MMA(0, 1, At, B1); PG8_BAR;
            PG8_LDA(At, 1, 1); PG8_STAGE(PG8_SA(1, 0), a3, voffA);
            PG8_BAR; PG8_WAIT_L(0); PG8_MMA(1, 0, At, B0); PG8_BAR; PG8_SCHED;
            PG8_STAGE(PG8_SB(1, 1), b3 + hstepB, voffB);
            PG8_WAIT_V(6); PG8_BAR; PG8_MMA(1, 1, At, B1); PG8_BAR;
            }
        }
        if constexpr (ALIGN_EPI) { if (wr == 0) PG8_BAR; }
        if constexpr (!Epi::AFTER_DRAIN) { E(acc, cur, wr, wc, fr, fq); S.done(cur); }
        if (!has_next) break;
#pragma unroll
        for (int a = 0; a < 2; ++a)
#pragma unroll
            for (int b = 0; b < 2; ++b)
#pragma unroll
                for (int m = 0; m < 4; ++m)
#pragma unroll
                    for (int n = 0; n < 2; ++n) acc[a][b][m][n] = (f32x4){0.f, 0.f, 0.f, 0.f};
        cur = nxt; cA = nA; cB = nB; ++ui;
        if constexpr (ALIGN_EPI) { if (wr == 1) PG8_BAR; }
    }
    PG8_WAIT_V(0);
    if constexpr (!ALIGN_EPI) { if (wr == 0) PG8_BAR; }
    PG8_BAR;
    if constexpr (Epi::AFTER_DRAIN) { E.fused(acc, cur, wr, wc, fr, fq, lds, wid, lane); S.done(cur); }
#undef PG8_SA
#undef PG8_SB
#undef PG8_STAGE
#undef PG8_LDA
#undef PG8_LDB
#undef PG8_MMA
#undef PG8_WAIT_V
#undef PG8_WAIT_L
#undef PG8_BAR
#undef PG8_SCHED
}
}
#include <hip/hip_bf16.h>
#include <cmath>
namespace attn_body {
using bf16=__hip_bfloat16;
using bf16x8=__attribute__((ext_vector_type(8)))short;
using s16x4=__attribute__((ext_vector_type(4)))short;
using f32x16=__attribute__((ext_vector_type(16)))float;
using u32x4=__attribute__((ext_vector_type(4)))unsigned;
constexpr int BATCH=8,NHEAD=8,SEQ=2048,D=64,QP=1536,KP=3328;
constexpr int NW=8,QBLK=32,QB=QBLK*NW,KVBLK=64,NQB=SEQ/QB;
constexpr int ATTN_UNIT_ROWS=QB;
__device__ __forceinline__ int crow(int r,int hi){return (r&3)+8*(r>>2)+4*hi;}
#define SBAR() __builtin_amdgcn_sched_barrier(0)
__device__ __forceinline__ void cmask(f32x16&p0,f32x16&p1,int jb,int qrel,int hi){
  const float NEG=-INFINITY; int kb=64*jb+4*hi;
  #pragma unroll
  for(int r=0;r<16;++r){int kv=kb+(r&3)+8*(r>>2); if(kv>qrel)p0[r]=NEG; if(kv+32>qrel)p1[r]=NEG;}
}

constexpr int NSLOT=3, SLOTB=8192;
constexpr int LDS_K=0, LDS_V=NSLOT*SLOTB, LDS_WS=2*NSLOT*SLOTB, LDS_OST=LDS_WS+NW*64*4, LDS_BYTES=LDS_OST+NW*4096;
constexpr float C2=0.125f*1.4426950408889634f;
__device__ __forceinline__ void glds16(const void*gsrc,unsigned lds_dst){unsigned keep;
  asm volatile("s_mov_b32 %0, m0\n\ts_mov_b32 m0, %2\n\ts_nop 0\n\tglobal_load_lds_dwordx4 %1, off\n\ts_mov_b32 m0, %0":"=&s"(keep):"v"(gsrc),"s"(lds_dst):"memory");}
__device__ __forceinline__ float max3f(float a,float b,float c){float r;asm("v_max3_f32 %0, %1, %2, %3":"=v"(r):"v"(a),"v"(b),"v"(c));return r;}
__device__ __forceinline__ float max2f(float a,float b){float r;asm("v_max_f32_e32 %0, %1, %2":"=v"(r):"v"(a),"v"(b));return r;}
__device__ __forceinline__ float fadd_s(float a,float b){float r;asm("v_add_f32_e32 %0, %1, %2":"=v"(r):"v"(a),"v"(b));return r;}
__device__ __forceinline__ float fsub_s(float a,float b){float r;asm("v_sub_f32_e32 %0, %1, %2":"=v"(r):"v"(a),"v"(b));return r;}
typedef float f32x2_t __attribute__((ext_vector_type(2))); typedef __bf16 bf16x2_t __attribute__((ext_vector_type(2)));
__device__ __forceinline__ unsigned cvtpk_s(float lo,float hi){f32x2_t v={lo,hi};bf16x2_t b=__builtin_convertvector(v,bf16x2_t);return __builtin_bit_cast(unsigned,b);}
#define WAIT_BAR(N) asm volatile("s_waitcnt vmcnt(" #N ") lgkmcnt(0)\n\ts_barrier":::"memory")

__device__ __forceinline__ void qkt(f32x16&p0,f32x16&p1,const char*Kslot,const bf16x8*qr,const f32x16&negm,int r32,int hi){
  const char*kb=Kslot+hi*1024+r32*16;
  #pragma unroll
  for(int d0=0;d0<4;++d0){
    const bf16x8 b0=*reinterpret_cast<const bf16x8*>(kb+d0*2048);
    const bf16x8 b1=*reinterpret_cast<const bf16x8*>(kb+d0*2048+512);
    if(d0==0){p0=__builtin_amdgcn_mfma_f32_32x32x16_bf16(b0,qr[0],negm,0,0,0);p1=__builtin_amdgcn_mfma_f32_32x32x16_bf16(b1,qr[0],negm,0,0,0);}
    else{p0=__builtin_amdgcn_mfma_f32_32x32x16_bf16(b0,qr[d0],p0,0,0,0);p1=__builtin_amdgcn_mfma_f32_32x32x16_bf16(b1,qr[d0],p1,0,0,0);}}
}
typedef __attribute__((address_space(3))) const char* lds_cptr;
typedef short v4i16_t __attribute__((ext_vector_type(4)));
__device__ __forceinline__ void kload8(bf16x8*kf,lds_cptr kp){
  kf[0]=*(const __attribute__((address_space(3))) bf16x8*)(kp);      kf[1]=*(const __attribute__((address_space(3))) bf16x8*)(kp+512);
  kf[2]=*(const __attribute__((address_space(3))) bf16x8*)(kp+2048); kf[3]=*(const __attribute__((address_space(3))) bf16x8*)(kp+2560);
  kf[4]=*(const __attribute__((address_space(3))) bf16x8*)(kp+4096); kf[5]=*(const __attribute__((address_space(3))) bf16x8*)(kp+4608);
  kf[6]=*(const __attribute__((address_space(3))) bf16x8*)(kp+6144); kf[7]=*(const __attribute__((address_space(3))) bf16x8*)(kp+6656);
}
__device__ __forceinline__ void kload2(bf16x8*kf,lds_cptr kp,int j){ kf[2*j]=*(const __attribute__((address_space(3))) bf16x8*)(kp+j*2048); kf[2*j+1]=*(const __attribute__((address_space(3))) bf16x8*)(kp+j*2048+512); }
__device__ __forceinline__ s16x4 vtr(lds_cptr p){ return __builtin_bit_cast(s16x4,__builtin_amdgcn_ds_read_tr16_b64_v4i16((__attribute__((address_space(3))) v4i16_t*)p)); }
__device__ __forceinline__ float rowmax(const f32x16&p0,const f32x16&p1){
  float a=max3f(p0[0],p0[1],p1[0]),b=max3f(p0[2],p0[3],p1[1]);a=max3f(a,p1[2],p1[3]);
  #pragma unroll
  for(int r=4;r<16;r+=4){a=max3f(a,p0[r],p0[r+1]);b=max3f(b,p0[r+2],p0[r+3]);a=max3f(a,p1[r],p1[r+1]);b=max3f(b,p1[r+2],p1[r+3]);}
  const float m=max2f(a,b);
  auto rr=__builtin_amdgcn_permlane32_swap(__float_as_uint(m),__float_as_uint(m),false,false);
  return max2f(__uint_as_float(rr[0]),__uint_as_float(rr[1]));
}
__device__ __forceinline__ void pv(f32x16*o,int vb,bf16x8 pa0,bf16x8 pa1,bf16x8 pa2,bf16x8 pa3){
  #pragma unroll
  for(int d0=0;d0<2;++d0){s16x4 lo[4],hi[4];
    #pragma unroll
    for(int ks=0;ks<4;++ks){
      asm volatile("ds_read_b64_tr_b16 %0,%1 offset:%c2":"=&v"(lo[ks]):"v"(vb),"i"(d0*4096+ks*1024):"memory");
      asm volatile("ds_read_b64_tr_b16 %0,%1 offset:%c2":"=&v"(hi[ks]):"v"(vb),"i"(d0*4096+ks*1024+512):"memory");}
    asm volatile("s_waitcnt lgkmcnt(0)":::"memory");SBAR();
    #define PK(k) (bf16x8){lo[k][0],lo[k][1],lo[k][2],lo[k][3],hi[k][0],hi[k][1],hi[k][2],hi[k][3]}
    o[d0]=__builtin_amdgcn_mfma_f32_32x32x16_bf16(pa0,PK(0),o[d0],0,0,0);
    o[d0]=__builtin_amdgcn_mfma_f32_32x32x16_bf16(pa1,PK(1),o[d0],0,0,0);
    o[d0]=__builtin_amdgcn_mfma_f32_32x32x16_bf16(pa2,PK(2),o[d0],0,0,0);
    o[d0]=__builtin_amdgcn_mfma_f32_32x32x16_bf16(pa3,PK(3),o[d0],0,0,0);
    #undef PK
  }
}

#ifndef ATTN_STORE16
#define ATTN_STORE16(p,v) (*(u32x4*)(p)=(v))
#endif
template<int THRL> __device__ __forceinline__ void attn_unit(int b,int h,int kvh,int qb,const bf16*Q,const bf16*__restrict__ K,const bf16*__restrict__ V,const bf16*__restrict__ Z,bf16*O,char*shm){
  int tid_=threadIdx.x; asm volatile("":"+v"(tid_)); const int tid=tid_,lane=tid&63,r32=lane&31,hi=lane>>5; const int wid=__builtin_amdgcn_readfirstlane(tid>>6);
  const long rowbase=(long)b*SEQ; const int q0=qb*QB;
  const bf16*Qw=Q+(rowbase+q0+wid*QBLK)*QP+h*D;
  const bf16*Kh=K+rowbase*KP+kvh*D,*Vh=V+rowbase*KP+kvh*D;
  const unsigned lds0=(unsigned)(uintptr_t)shm;
  float*wsf=(float*)(shm+LDS_WS)+wid*64;
  const bf16*ksrc=Kh+(long)lane*KP+wid*8;
  const bf16*vsrc=Vh+(long)(16*(wid&3)+(lane>>2))*KP+(wid>>2)*32+(lane&3)*8;
  const unsigned kdst=lds0+LDS_K+wid*1024, vdst=lds0+LDS_V+wid*1024;
  #define DMA_K(t,slot) glds16(ksrc+(long)(t)*KVBLK*KP,(unsigned)__builtin_amdgcn_readfirstlane(kdst+(slot)))
  #define DMA_V(t,slot) glds16(vsrc+(long)(t)*KVBLK*KP,(unsigned)__builtin_amdgcn_readfirstlane(vdst+(slot)))
  const int vb0=(int)(lds0+LDS_V)+((lane>>4)&1)*32+(lane&3)*8+(4*hi+((lane&15)>>2))*64;
  const char*Kbase=shm+LDS_K; bf16x8 kf[8];
  const lds_cptr shm3=(lds_cptr)shm; const lds_cptr kp0=shm3+LDS_K+hi*1024+r32*16; const lds_cptr vp0=shm3+LDS_V+((lane>>4)&1)*32+(lane&3)*8+(4*hi+((lane&15)>>2))*64;
  const int NT=SEQ/KVBLK;
  DMA_K(0,0);DMA_V(0,0);DMA_K(1,SLOTB);
  bf16x8 qr[4];
  #pragma unroll
  for(int d0=0;d0<4;++d0)qr[d0]=*reinterpret_cast<const bf16x8*>(&Qw[(long)r32*QP+d0*16+hi*8]);
  float mhat=0.f,l_reg=0.f;f32x16 o[2];o[0]=f32x16{};o[1]=f32x16{};f32x16 negm=f32x16{};asm volatile("":"+v"(negm));

  #define CMASK(P0,P1,t) do{}while(0)
  bool resc=false;
  #define START(P0,P1) do{ const float rm=rowmax(P0,P1); resc=false; \
    { const float dl=rm; mhat=fadd_s(mhat,dl); \
      _Pragma("unroll") for(int r=0;r<16;++r){P0[r]=fsub_s(P0[r],dl);P1[r]=fsub_s(P1[r],dl);} \
      _Pragma("unroll") for(int r=0;r<16;++r)negm[r]=-mhat; asm volatile("":"+v"(negm)); } \
    _Pragma("unroll") for(int r=0;r<16;++r)P0[r]=__builtin_amdgcn_exp2f(P0[r]); }while(0)
  #define RESC() do{ if(resc){ asm volatile("s_waitcnt lgkmcnt(0)":::"memory"); \
      _Pragma("unroll") for(int d_=0;d_<2;++d_) _Pragma("unroll") for(int r=0;r<16;++r)o[d_][r]*=wsf[crow(r,hi)]; } }while(0)
  f32x16 pA0,pA1,pB0,pB1;
  int sl_prev=0,sl_cur=0,sl_next=SLOTB;
  #define ROT() do{sl_prev=sl_cur;sl_cur=sl_next;sl_next=(sl_next==(NSLOT-1)*SLOTB)?0:sl_next+SLOTB;}while(0)
  DMA_K(2,2*SLOTB);
  WAIT_BAR(3);
  qkt(pA0,pA1,Kbase,qr,negm,r32,hi);asm volatile("s_nop 15\n\ts_nop 7":"+v"(pA0),"+v"(pA1));CMASK(pA0,pA1,0);
  START(pA0,pA1);
  _Pragma("unroll") for(int r=0;r<16;++r)pA1[r]=__builtin_amdgcn_exp2f(pA1[r]);
  WAIT_BAR(0);
  DMA_K(3,0);DMA_V(1,SLOTB);
  ROT();
  kload8(kf,kp0+sl_cur);
  WAIT_BAR(2);
  s16x4 vlo[8],vhi[8]; u32x4 pw0,pw1,pw2,pw3;
  #define PKW(P,B) cvtpk_s(P[B],P[B+1])
  #define PAF(k) __builtin_bit_cast(bf16x8,pw##k)
  #define VFR(i) (bf16x8){vlo[i][0],vlo[i][1],vlo[i][2],vlo[i][3],vhi[i][0],vhi[i][1],vhi[i][2],vhi[i][3]}
  #define PIN(x) asm volatile("":"+v"(x))
  #define MX3(a,b,c) __builtin_fmaxf(__builtin_fmaxf((a),(b)),(c))
  #define GAPA(MF,A0,A1,A2,A3,W0,W1,PW) do{ MF; sacc+=A0; sacc+=A1; sacc+=A2; sacc+=A3; PIN(sacc); W0; W1; PIN(PW); SBAR(); }while(0)
  #define EX(v) __builtin_amdgcn_exp2f(v)
  #define GAPB(MF,X,B) do{ MF; X[B]=EX(X[B]); X[B+1]=EX(X[B+1]); X[B+2]=EX(X[B+2]); X[B+3]=EX(X[B+3]); PIN(X); SBAR(); }while(0)
  #define VRD(i) do{ vlo[i]=vtr(vp_+(((i)>>2)*4096+((i)&3)*1024)); vhi[i]=vtr(vp_+(((i)>>2)*4096+((i)&3)*1024+512)); }while(0)
  #define KRD(G,j) do{ if(G){ kload2(kf,kp0+sl_next,j); SBAR(); } }while(0)
  #define STEP(C0,C1,P0,P1,t,GK,GV,GL) do{ SBAR(); \
    const lds_cptr vp_=vp0+sl_prev; \
    VRD(0); SBAR(); float sacc=(P0[0]+P0[1]); \
    GAPA(C0=__builtin_amdgcn_mfma_f32_32x32x16_bf16(kf[0],qr[0],negm,0,0,0), P0[2],P0[3],P0[4],P0[5],     pw0[0]=PKW(P0,0), pw0[1]=PKW(P0,2), pw0); \
    VRD(4); SBAR(); GAPA(C1=__builtin_amdgcn_mfma_f32_32x32x16_bf16(kf[1],qr[0],negm,0,0,0), P0[6],P0[7],P0[8],P0[9],     pw0[2]=PKW(P0,4), pw0[3]=PKW(P0,6), pw0); \
    VRD(1); SBAR(); GAPA(C0=__builtin_amdgcn_mfma_f32_32x32x16_bf16(kf[2],qr[1],C0,0,0,0),   P0[10],P0[11],P0[12],P0[13], pw1[0]=PKW(P0,8), pw1[1]=PKW(P0,10), pw1); \
    VRD(5); SBAR(); GAPA(C1=__builtin_amdgcn_mfma_f32_32x32x16_bf16(kf[3],qr[1],C1,0,0,0),   P0[14],P0[15],P1[0],P1[1],   pw1[2]=PKW(P0,12),pw1[3]=PKW(P0,14), pw1); \
    VRD(2); SBAR(); GAPA(C0=__builtin_amdgcn_mfma_f32_32x32x16_bf16(kf[4],qr[2],C0,0,0,0),   P1[2],P1[3],P1[4],P1[5],     pw2[0]=PKW(P1,0), pw2[1]=PKW(P1,2), pw2); \
    VRD(6); SBAR(); GAPA(C1=__builtin_amdgcn_mfma_f32_32x32x16_bf16(kf[5],qr[2],C1,0,0,0),   P1[6],P1[7],P1[8],P1[9],     pw2[2]=PKW(P1,4), pw2[3]=PKW(P1,6), pw2); \
    VRD(3); SBAR(); GAPA(C0=__builtin_amdgcn_mfma_f32_32x32x16_bf16(kf[6],qr[3],C0,0,0,0),   P1[10],P1[11],P1[12],P1[13], pw3[0]=PKW(P1,8), pw3[1]=PKW(P1,10), pw3); \
    VRD(7); SBAR(); GAPA(C1=__builtin_amdgcn_mfma_f32_32x32x16_bf16(kf[7],qr[3],C1,0,0,0),   P1[14],P1[15],0.f,0.f,       pw3[2]=PKW(P1,12),pw3[3]=PKW(P1,14), pw3); \
    l_reg+=sacc; \
    if(GK){DMA_K((t)+3,sl_cur);} if(GV){DMA_V((t)+1,sl_next);} \
    CMASK(C0,C1,t); \
    { float a=MX3(C0[0],C0[1],C1[0]),b=MX3(C0[2],C0[3],C1[1]); a=MX3(a,C1[2],C1[3]); \
      _Pragma("unroll") for(int r=4;r<16;r+=4){a=MX3(a,C0[r],C0[r+1]);b=MX3(b,C0[r+2],C0[r+3]);a=MX3(a,C1[r],C1[r+1]);b=MX3(b,C1[r+2],C1[r+3]);} \
      float rm=__builtin_fmaxf(a,b); { auto rr=__builtin_amdgcn_permlane32_swap(__float_as_uint(rm),__float_as_uint(rm),false,false); rm=__builtin_fmaxf(__uint_as_float(rr[0]),__uint_as_float(rr[1])); } \
      resc=false; \
      if(__builtin_expect(__any(rm>(float)THRL),0)){ const float dl=__builtin_fmaxf(rm,0.f); mhat+=dl; \
        _Pragma("unroll") for(int r=0;r<16;++r){C0[r]-=dl;C1[r]-=dl;} \
        _Pragma("unroll") for(int r=0;r<16;++r)negm[r]=-mhat; asm volatile("":"+v"(negm)); \
        const float f=__builtin_amdgcn_exp2f(-dl); l_reg*=f; if(hi==0)wsf[r32]=f; resc=true; } } \
    SBAR(); \
    GAPB(o[0]=__builtin_amdgcn_mfma_f32_32x32x16_bf16(PAF(0),VFR(0),o[0],0,0,0), C0,0); \
    GAPB(o[1]=__builtin_amdgcn_mfma_f32_32x32x16_bf16(PAF(0),VFR(4),o[1],0,0,0), C0,4); \
    KRD(GL,0); GAPB(o[0]=__builtin_amdgcn_mfma_f32_32x32x16_bf16(PAF(1),VFR(1),o[0],0,0,0), C0,8); \
    KRD(GL,1); GAPB(o[1]=__builtin_amdgcn_mfma_f32_32x32x16_bf16(PAF(1),VFR(5),o[1],0,0,0), C0,12); \
    KRD(GL,2); GAPB(o[0]=__builtin_amdgcn_mfma_f32_32x32x16_bf16(PAF(2),VFR(2),o[0],0,0,0), C1,0); \
    KRD(GL,3); GAPB(o[1]=__builtin_amdgcn_mfma_f32_32x32x16_bf16(PAF(2),VFR(6),o[1],0,0,0), C1,4); \
    GAPB(o[0]=__builtin_amdgcn_mfma_f32_32x32x16_bf16(PAF(3),VFR(3),o[0],0,0,0), C1,8); \
    GAPB(o[1]=__builtin_amdgcn_mfma_f32_32x32x16_bf16(PAF(3),VFR(7),o[1],0,0,0), C1,12); \
    }while(0)
  int t=1;
  #undef CMASK
  #define CMASK(P0,P1,t) do{}while(0)
  for(;t+5<NT;t+=2){
    STEP(pB0,pB1,pA0,pA1,t,true,true,true);     WAIT_BAR(2); RESC(); ROT();
    STEP(pA0,pA1,pB0,pB1,t+1,true,true,true);   WAIT_BAR(2); RESC(); ROT();
  }
  #undef CMASK
  #define CMASK(P0,P1,t) do{}while(0)
  #define ENDW(tt) do{ if((tt)+3<NT){WAIT_BAR(2);} else if((tt)+2<NT){WAIT_BAR(1);} else {WAIT_BAR(0);} }while(0)
  for(;t+1<NT;t+=2){
    STEP(pB0,pB1,pA0,pA1,t,(t+3<NT),(t+1<NT),(t+1<NT));       ENDW(t);   RESC(); ROT();
    STEP(pA0,pA1,pB0,pB1,t+1,(t+4<NT),(t+2<NT),(t+2<NT));     ENDW(t+1); RESC(); ROT();
  }
  STEP(pB0,pB1,pA0,pA1,NT-1,false,false,false); RESC();
  { float sacc=pB0[0]+pB0[1]; _Pragma("unroll") for(int r=2;r<16;++r)sacc+=pB0[r]; _Pragma("unroll") for(int r=0;r<16;++r)sacc+=pB1[r]; l_reg+=sacc;
    pw0=(u32x4){PKW(pB0,0),PKW(pB0,2),PKW(pB0,4),PKW(pB0,6)};pw1=(u32x4){PKW(pB0,8),PKW(pB0,10),PKW(pB0,12),PKW(pB0,14)};pw2=(u32x4){PKW(pB1,0),PKW(pB1,2),PKW(pB1,4),PKW(pB1,6)};pw3=(u32x4){PKW(pB1,8),PKW(pB1,10),PKW(pB1,12),PKW(pB1,14)};
    SBAR(); pv(o,vb0+sl_cur,PAF(0),PAF(1),PAF(2),PAF(3)); }
  #undef PKW
  #undef PAF
  #undef VFR
  #undef PIN
  #undef MX3
  #undef GAPA
  #undef GAPB
  #undef EX
  #undef VRD
  #undef KRD
  #undef STEP
  #undef ENDW
  {auto rr=__builtin_amdgcn_permlane32_swap(__float_as_uint(l_reg),__float_as_uint(l_reg),false,false);l_reg=__uint_as_float(rr[0])+__uint_as_float(rr[1]);}
  if(hi==0)wsf[32+r32]=l_reg;asm volatile("s_waitcnt lgkmcnt(0)":::"memory");
  float rli[16];
  #pragma unroll
  for(int r=0;r<16;++r)rli[r]=__builtin_amdgcn_rcpf(wsf[32+crow(r,hi)]);
  bf16*Ow=O+(rowbase+q0+wid*QBLK)*QP+h*D; const bf16*Zw=Z+(rowbase+q0+wid*QBLK)*KP+h*D;
  { bf16*stg=(bf16*)(shm+LDS_OST)+wid*2048;
    #pragma unroll
    for(int r=0;r<16;++r){const int orow=crow(r,hi);
      #pragma unroll
      for(int d0=0;d0<2;++d0)stg[orow*64+d0*32+r32]=__float2bfloat16(o[d0][r]*rli[r]);}
    asm volatile("s_waitcnt lgkmcnt(0)":::"memory");
    #pragma unroll
    for(int i=0;i<4;++i){const int row=i*8+(lane>>3),ch=lane&7; const u32x4 v=*(const u32x4*)(stg+row*64+ch*8); const u32x4 zz=*(const u32x4*)(Zw+(long)row*KP+ch*8); u32x4 w;
      #pragma unroll
      for(int e=0;e<4;++e){const float a0=__uint_as_float(v[e]<<16)*__uint_as_float(zz[e]<<16),a1=__uint_as_float(v[e]&0xffff0000u)*__uint_as_float(zz[e]&0xffff0000u); w[e]=cvtpk_s(a0,a1);}
      ATTN_STORE16(Ow+(long)row*QP+ch*8,w);} }
  asm volatile("s_waitcnt lgkmcnt(0)\n\ts_barrier":::"memory");
  #undef DMA_K
  #undef DMA_V
  #undef CMASK
  #undef START
  #undef RESC
  #undef ROT
}
constexpr int ATTN_LDS_BYTES=LDS_BYTES;
struct AttnTensors { const bf16* Q; const bf16* K; const bf16* V; const bf16* Z; bf16* O; };
template<int THRL=8> __device__ __forceinline__ void attn_phase(char*lds,const AttnTensors&T,int vcu,int G){
  for(int U=vcu;U<BATCH*NHEAD*NQB;U+=G){ const int grp=U>>5,loc=U&31; const int b=grp&7,kvh=grp>>3,h=kvh*4+(loc>>3),qb=loc&7;
    attn_unit<THRL>(b,h,kvh,qb,T.Q,T.K,T.V,T.Z,T.O,lds); }
}
#undef SBAR
#undef WAIT_BAR
}
constexpr int NWAVES = 8;
constexpr int BATCH = 8, SEQ = 2048, D = 1024, M = BATCH * SEQ, DEPTH = 2;
constexpr int INW = 7936, NMIX = 4864, NGATE = 3072, QUP = 1536, RESTP = 3328;
constexpr float LN_EPS = 1e-5f;
using pg8::LOG2E; using pg8::C2;
constexpr float ALPHA = 1.4142135623730951f;
constexpr size_t MiB = 1u << 20;
constexpr size_t WS_BIASV = 0;
constexpr size_t WS_WIN = 1 * MiB;
constexpr size_t WS_WBR = 32 * MiB;
constexpr size_t WS_WOUT = 38 * MiB;
constexpr size_t WS_SGW = 42 * MiB;
constexpr size_t WS_XN = 44 * MiB;
constexpr size_t WS_QU = 76 * MiB;
constexpr size_t WS_REST = 124 * MiB;
constexpr size_t WS_END = 228 * MiB;
constexpr int RING_OFF = 0;
constexpr int LDS_BYTES = 163840;

#define GAS __attribute__((address_space(1)))
#define LAS __attribute__((address_space(3)))
typedef unsigned short bf16;
typedef unsigned v4u __attribute__((ext_vector_type(4)));
typedef unsigned v2u __attribute__((ext_vector_type(2)));
typedef float f32x4 __attribute__((ext_vector_type(4)));
typedef short bf16x8 __attribute__((ext_vector_type(8)));
#define LDS_WAIT() asm volatile("s_waitcnt lgkmcnt(0)" ::: "memory")
__device__ __forceinline__ unsigned f2bf(float f) { unsigned u = __builtin_bit_cast(unsigned, f); return (u + 0x7fffu + ((u >> 16) & 1u)) >> 16; }
__device__ __forceinline__ unsigned pk2(float lo, float hi) { return f2bf(lo) | (f2bf(hi) << 16); }
__device__ __forceinline__ float bflo(unsigned w) { return __uint_as_float(w << 16); }
__device__ __forceinline__ float bfhi(unsigned w) { return __uint_as_float(w & 0xffff0000u); }
__device__ __forceinline__ float wave_sum(float v) {
#pragma unroll
    for (int o = 1; o < 64; o <<= 1) v += __shfl_xor(v, o);
    return v;
}
__host__ __device__ __forceinline__ int v2l(int vc) {
    if (vc < 512) return vc;
    if (vc < 1024) return vc - 512 + 2048;
    if (vc < 1536) return vc - 1024 + 3328;
    if (vc < 2048) return vc - 1536 + 512;
    if (vc < 2560) return vc - 2048 + 1024;
    if (vc < 3072) return vc - 2560 + 1536;
    if (vc < 3200) return vc - 3072 + 2560;
    if (vc < 3328) return vc - 3200 + 2688;
    if (vc < 3840) return vc - 3328 + 2816;
    return vc;
}
__device__ __forceinline__ void transpose_item(const float* W, int N, int k0, int n0, bf16* WT, int ldt, int dst_row0, int kofs, LAS float* scr, int lane) {
#pragma unroll 8
    for (int i = 0; i < 32; ++i) { const int kk = 2 * i + (lane >> 5); scr[kk * 33 + (lane & 31)] = W[(size_t)(k0 + kk) * N + n0 + (lane & 31)]; }
    LDS_WAIT(); asm volatile("" ::: "memory");
    const int c = lane & 7;
#pragma unroll
    for (int j = 0; j < 4; ++j) { const int n = (lane >> 3) + 8 * j; const LAS float* s = scr + (8 * c) * 33 + n;
        v4u o; o.x = pk2(s[0 * 33], s[1 * 33]); o.y = pk2(s[2 * 33], s[3 * 33]); o.z = pk2(s[4 * 33], s[5 * 33]); o.w = pk2(s[6 * 33], s[7 * 33]);
        *(GAS v4u*)(WT + (size_t)(dst_row0 + n) * ldt + kofs + k0 + 8 * c) = o; }
    LDS_WAIT(); asm volatile("" ::: "memory");
}
__device__ __forceinline__ void ln_row(const float* xrow, const float* g, const float* bta, float* orow, bf16* brow, int lane) {
    const GAS f32x4* xr = (const GAS f32x4*)xrow + lane;
    f32x4 v[4]; float s = 0.f;
#pragma unroll
    for (int j = 0; j < 4; ++j) { v[j] = xr[64 * j]; s += (v[j].x + v[j].y) + (v[j].z + v[j].w); }
    const float mean = wave_sum(s) * (1.f / D); float s2 = 0.f;
#pragma unroll
    for (int j = 0; j < 4; ++j) { v[j] = v[j] - mean; s2 += (v[j].x * v[j].x + v[j].y * v[j].y) + (v[j].z * v[j].z + v[j].w * v[j].w); }
    const float rstd = 1.f / sqrtf(wave_sum(s2) * (1.f / D) + LN_EPS);
    GAS f32x4* o4 = (GAS f32x4*)orow + lane; GAS v2u* o8 = (GAS v2u*)brow + lane;
#pragma unroll
    for (int j = 0; j < 4; ++j) { const f32x4 gg = ((const GAS f32x4*)g)[lane + 64 * j], bb = ((const GAS f32x4*)bta)[lane + 64 * j]; const f32x4 y = v[j] * rstd * gg + bb;
        o4[64 * j] = y; v2u w; w.x = pk2(y.x, y.y); w.y = pk2(y.z, y.w); o8[64 * j] = w; }
}

constexpr int NA_K = 0, NA_V = 65536, NA_MS = 131072, NA_ML = NA_MS + 4 * 16 * 68 * 4, NA_RP = NA_ML + 8 * 32 * 4, NA_END = NA_RP + 480 * 4;
static_assert(NA_END <= LDS_BYTES, "NA LDS map");
__device__ __forceinline__ void na_stage_write(LAS unsigned char* lds, int slot, int key, int dc, v4u kv, v4u vv) {
    *(LAS v4u*)(lds + NA_K + slot * 8192 + key * 128 + ((dc ^ (key & 7)) << 4)) = kv;
    LAS unsigned char* vb = lds + NA_V + slot * 8192 + (dc * 8) * 128 + (key & 7) * 2; const int kc = key >> 3;
#pragma unroll
    for (int e = 0; e < 4; ++e) {
        *(LAS unsigned short*)(vb + (2 * e) * 128 + ((kc ^ (2 * e)) << 4)) = (unsigned short)(vv[e] & 0xffffu);
        *(LAS unsigned short*)(vb + (2 * e + 1) * 128 + ((kc ^ (2 * e + 1)) << 4)) = (unsigned short)(vv[e] >> 16); }
}
__device__ __forceinline__ void na_unit(LAS unsigned char* lds, int b, int h, int oct, bf16* QU, const bf16* REST, const float* rpb) {
    int tid_ = threadIdx.x; asm volatile("" : "+v"(tid_)); const int tid = tid_, lane = tid & 63, wid = __builtin_amdgcn_readfirstlane(tid >> 6), fr = lane & 15, fq = lane >> 4;
    const int qb = wid & 3, kh = wid >> 2, c0 = 16 * qb, w0 = min(max(16 * qb - 8, 0), 32);
    bf16* Qb = QU + (size_t)b * SEQ * QUP + h * 64;
    const bf16* Kb = REST + (size_t)b * SEQ * RESTP + h * 64; const bf16* Vb = Kb + 512; const bf16* Zb = Kb + 1024;
    LAS float* RP = (LAS float*)(lds + NA_RP); LAS float* ML = (LAS float*)(lds + NA_ML); LAS float* MS = (LAS float*)(lds + NA_MS);
    if (tid < 465) RP[tid] = rpb[h * 465 + tid] * LOG2E;
    const int skey = tid >> 3, sdc = tid & 7;
    int rs = min(max(8 * oct - 4, 0), 24);
#pragma unroll
    for (int half = 0; half < 2; ++half) { v4u kv[4], vv[4];
#pragma unroll
        for (int j = 0; j < 4; ++j) { const int kr = rs + half * 4 + j; const size_t off = (size_t)(kr * 64 + skey) * RESTP + sdc * 8; kv[j] = *(const v4u*)(Kb + off); vv[j] = *(const v4u*)(Vb + off); }
#pragma unroll
        for (int j = 0; j < 4; ++j) { const int kr = rs + half * 4 + j; na_stage_write(lds, kr & 7, skey, sdc, kv[j], vv[j]); } }
    __syncthreads();
    for (int i = 0; i < 8; ++i) {
        const int r = 8 * oct + i;
        const int rs_next = (i < 7) ? min(max(r + 1 - 4, 0), 24) : rs; const bool adv = rs_next > rs;
        v4u pk = (v4u){0u, 0u, 0u, 0u}, pv = pk;
        if (adv) { const size_t off = (size_t)((rs_next + 7) * 64 + skey) * RESTP + sdc * 8; pk = *(const v4u*)(Kb + off); pv = *(const v4u*)(Vb + off); }
        const bf16* qp = Qb + (size_t)(r * 64 + c0 + fr) * QUP + fq * 8;
        const bf16x8 q0 = *(const bf16x8*)qp, q1 = *(const bf16x8*)(qp + 32);
        const int c = c0 + fr, cs = min(max(c - 8, 0), 48);
        float sc[4][8]; float mx = -1e30f;
        const int keya = w0 + 8 * (fr >> 2) + (fr & 3);
#pragma unroll
        for (int jr = 0; jr < 4; ++jr) { const int kr = rs + kh * 4 + jr, slot = kr & 7;
            const LAS unsigned char* kb = lds + NA_K + slot * 8192;
            const int ka = keya, kbk = keya + 4;
            const bf16x8 a0 = *(const LAS bf16x8*)(kb + ka * 128 + ((fq ^ (ka & 7)) << 4)), a1 = *(const LAS bf16x8*)(kb + ka * 128 + (((4 + fq) ^ (ka & 7)) << 4));
            const bf16x8 b0 = *(const LAS bf16x8*)(kb + kbk * 128 + ((fq ^ (kbk & 7)) << 4)), b1 = *(const LAS bf16x8*)(kb + kbk * 128 + (((4 + fq) ^ (kbk & 7)) << 4));
            f32x4 sa = (f32x4){0.f, 0.f, 0.f, 0.f}, sb = sa;
            sa = __builtin_amdgcn_mfma_f32_16x16x32_bf16(a0, q0, sa, 0, 0, 0); sa = __builtin_amdgcn_mfma_f32_16x16x32_bf16(a1, q1, sa, 0, 0, 0);
            sb = __builtin_amdgcn_mfma_f32_16x16x32_bf16(b0, q0, sb, 0, 0, 0); sb = __builtin_amdgcn_mfma_f32_16x16x32_bf16(b1, q1, sb, 0, 0, 0);
            const LAS float* rprow = RP + (kr - r + 7) * 31 + 15 - c;
#pragma unroll
            for (int jj = 0; jj < 8; ++jj) { const int k = w0 + 8 * fq + jj; const bool ok = (k >= cs) && (k < cs + 16);
                const float s = (jj < 4 ? sa[jj] : sb[jj - 4]) + (ok ? rprow[k] : 0.f);
                sc[jr][jj] = ok ? s : -1e30f; mx = fmaxf(mx, sc[jr][jj]); } }
        mx = fmaxf(mx, __shfl_xor(mx, 16)); mx = fmaxf(mx, __shfl_xor(mx, 32));
        float ls = 0.f; bf16x8 pa[4];
#pragma unroll
        for (int jr = 0; jr < 4; ++jr) { float p[8];
#pragma unroll
            for (int jj = 0; jj < 8; ++jj) { p[jj] = __builtin_amdgcn_exp2f(sc[jr][jj] - mx); ls += p[jj]; }
            v4u w; w.x = pk2(p[0], p[1]); w.y = pk2(p[2], p[3]); w.z = pk2(p[4], p[5]); w.w = pk2(p[6], p[7]); pa[jr] = __builtin_bit_cast(bf16x8, w); }
        ls += __shfl_xor(ls, 16); ls += __shfl_xor(ls, 32);
        f32x4 o[4];
#pragma unroll
        for (int db = 0; db < 4; ++db) { o[db] = (f32x4){0.f, 0.f, 0.f, 0.f}; const int d = 16 * db + fr;
#pragma unroll
            for (int jr = 0; jr < 4; ++jr) { const int slot = (rs + kh * 4 + jr) & 7;
                const bf16x8 vb = *(const LAS bf16x8*)(lds + NA_V + slot * 8192 + d * 128 + ((((w0 >> 3) + fq) ^ (d & 7)) << 4));
                o[db] = __builtin_amdgcn_mfma_f32_16x16x32_bf16(pa[jr], vb, o[db], 0, 0, 0); } }
        if (fq == 0) { ML[wid * 32 + fr] = mx; ML[wid * 32 + 16 + fr] = ls; }
        if (kh == 1) {
#pragma unroll
            for (int db = 0; db < 4; ++db)
#pragma unroll
                for (int j = 0; j < 4; ++j) MS[(qb * 16 + 4 * fq + j) * 68 + 16 * db + fr] = o[db][j]; }
        __syncthreads();
        if (adv) na_stage_write(lds, (rs_next + 7) & 7, skey, sdc, pk, pv);
        if (kh == 0) {
#pragma unroll
            for (int j = 0; j < 4; ++j) { const int q = 4 * fq + j;
                const float m0 = ML[wid * 32 + q], l0 = ML[wid * 32 + 16 + q], m1 = ML[(wid + 4) * 32 + q], l1 = ML[(wid + 4) * 32 + 16 + q];
                const float mt = fmaxf(m0, m1), a0 = __builtin_amdgcn_exp2f(m0 - mt), a1 = __builtin_amdgcn_exp2f(m1 - mt), inv = 1.0f / (l0 * a0 + l1 * a1);
                const size_t tok = (size_t)(r * 64 + c0 + q);
#pragma unroll
                for (int db = 0; db < 4; ++db) { const int d = 16 * db + fr;
                    const float ov = (o[db][j] * a0 + MS[(qb * 16 + q) * 68 + d] * a1) * inv;
                    const float z = __uint_as_float((unsigned)Zb[tok * RESTP + d] << 16);
                    Qb[tok * QUP + d] = (bf16)f2bf(ov * z); } } }
        __syncthreads();
        rs = rs_next;
    }
}

__device__ __forceinline__ void sg_unit(LAS unsigned char* lds, int b, int chunk, int gh, bf16* QU, const bf16* REST, const float* lng, const float* lnb, const bf16* sgw, const float* sgb) {
    int tid_ = threadIdx.x; asm volatile("" : "+v"(tid_)); const int tid = tid_, lane = tid & 63, wid = __builtin_amdgcn_readfirstlane(tid >> 6), fr = lane & 15, fq = lane >> 4;
    const size_t tok0 = (size_t)b * SEQ + chunk * 128;
    const bf16* Vp = REST + tok0 * RESTP + 2304; const bf16* Zp = REST + tok0 * RESTP + 2816; bf16* Up = QU + tok0 * QUP + 1024;
    {
        f32x4 g0 = *(const f32x4*)(lng + lane * 8), g1 = *(const f32x4*)(lng + lane * 8 + 4), b0 = *(const f32x4*)(lnb + lane * 8), b1 = *(const f32x4*)(lnb + lane * 8 + 4);
        const bool mine = (lane >> 5) == gh; const int cl0 = (lane & 31) * 8;
        for (int i = 0; i < 16; ++i) { const int n = wid * 16 + i;
            const v4u raw = *(const v4u*)(Vp + (size_t)n * RESTP + lane * 8);
            float x[8];
#pragma unroll
            for (int e = 0; e < 4; ++e) { x[2 * e] = bflo(raw[e]); x[2 * e + 1] = bfhi(raw[e]); }
            float s = 0.f;
#pragma unroll
            for (int e = 0; e < 8; ++e) s += x[e];
            const float mean = wave_sum(s) * (1.0f / 512.0f); float s2 = 0.f;
#pragma unroll
            for (int e = 0; e < 8; ++e) { x[e] -= mean; s2 += x[e] * x[e]; }
            const float rstd = 1.f / sqrtf(wave_sum(s2) * (1.0f / 512.0f) + LN_EPS);
            if (mine) {
#pragma unroll
                for (int e = 0; e < 8; ++e) { const float y = x[e] * rstd * (e < 4 ? g0[e] : g1[e - 4]) + (e < 4 ? b0[e] : b1[e - 4]); const int cl = cl0 + e;
                    *(LAS unsigned short*)(lds + cl * 256 + (((n >> 3) ^ (cl & 15)) << 4) + (n & 7) * 2) = (unsigned short)f2bf(y); } }
        }
    }
    __syncthreads();
    {
        const int gl = wid & 3, g = 4 * gh + gl, mh = wid >> 2;
        const bf16* Wg = sgw + (size_t)g * 128 * 128;
        f32x4 acc[4][4];
#pragma unroll
        for (int db = 0; db < 4; ++db)
#pragma unroll
            for (int mb = 0; mb < 4; ++mb) acc[db][mb] = (f32x4){0.f, 0.f, 0.f, 0.f};
#pragma unroll
        for (int ks = 0; ks < 4; ++ks) { bf16x8 af[4], bfr[4];
#pragma unroll
            for (int db = 0; db < 4; ++db) { const int cl = gl * 64 + 16 * db + fr; af[db] = *(const LAS bf16x8*)(lds + cl * 256 + (((ks * 4 + fq) ^ (cl & 15)) << 4)); }
#pragma unroll
            for (int mb = 0; mb < 4; ++mb) bfr[mb] = *(const bf16x8*)(Wg + (size_t)(64 * mh + 16 * mb + fr) * 128 + ks * 32 + fq * 8);
#pragma unroll
            for (int db = 0; db < 4; ++db)
#pragma unroll
                for (int mb = 0; mb < 4; ++mb) acc[db][mb] = __builtin_amdgcn_mfma_f32_16x16x32_bf16(af[db], bfr[mb], acc[db][mb], 0, 0, 0); }
#pragma unroll
        for (int mb = 0; mb < 4; ++mb) { const int m = 64 * mh + 16 * mb + fr; const float bs = sgb[g * 128 + m];
#pragma unroll
            for (int db = 0; db < 4; ++db) { const int c = 64 * g + 16 * db + 4 * fq;
                const v2u uu = *(const v2u*)(Up + (size_t)m * QUP + c), zz = *(const v2u*)(Zp + (size_t)m * RESTP + c); const f32x4 a = acc[db][mb];
                v2u w; w.x = pk2(bflo(uu.x) * (a[0] + bs) * bflo(zz.x), bfhi(uu.x) * (a[1] + bs) * bfhi(zz.x)); w.y = pk2(bflo(uu.y) * (a[2] + bs) * bflo(zz.y), bfhi(uu.y) * (a[3] + bs) * bfhi(zz.y));
                *(v2u*)(Up + (size_t)m * QUP + c) = w; } }
    }
    __syncthreads();
}
struct Args {
    const float *x, *ln_in_g, *ln_in_b, *w_in, *b_in, *na_rpb, *q_norm_g, *k_norm_g, *sg_ln_g, *sg_ln_b, *sg_w, *sg_b, *w_br_a, *w_br_b, *w_br_c, *w_out, *b_out, *ln_post_g, *ln_post_b;
    float* out; unsigned char* ws;
};
__global__ void __launch_bounds__(NWAVES * 64, 2) mega_fwd(Args a) {
    extern __shared__ __attribute__((aligned(16))) unsigned char lds_raw[];
    cg::grid_group grid = cg::this_grid();
    LAS unsigned char* lds = (LAS unsigned char*)lds_raw;
    const int tid = threadIdx.x, lane = tid & 63, wave = __builtin_amdgcn_readfirstlane(tid >> 6);
    const int G = gridDim.x, bx = blockIdx.x; const int vcu = (G % 8 == 0) ? (bx % 8) * (G / 8) + bx / 8 : bx;
    unsigned char* ws = a.ws;
    float* BIASV = (float*)(ws + WS_BIASV);
    bf16* WIN = (bf16*)(ws + WS_WIN); bf16* WBR = (bf16*)(ws + WS_WBR); bf16* WOUT = (bf16*)(ws + WS_WOUT); bf16* SGW = (bf16*)(ws + WS_SGW);
    bf16* XN = (bf16*)(ws + WS_XN); bf16* QU = (bf16*)(ws + WS_QU); bf16* REST = (bf16*)(ws + WS_REST); bf16* GT = REST;
    float* H = a.out;
    const int gw = vcu * NWAVES + wave, NGW = G * NWAVES;

    {
        LAS float* scr = (LAS float*)(lds + wave * 16384);
        constexpr int I_IN = 16 * (INW / 32), I_BR = 8 * 32, I_OUT = 16 * 32;
        constexpr int PER_L = I_IN + 3 * I_BR + I_OUT, NITEMS = DEPTH * PER_L;
        for (int it = gw; it < NITEMS; it += NGW) {
            const int l = it / PER_L; int r = it % PER_L;
            if (r < I_IN) { const int kb = r / (INW / 32), pb = r % (INW / 32);
                const int tile = pb >> 3, wblk = pb & 7, bj = wblk >> 2, wc = wblk & 3; const int vc0 = tile * 256 + wc * 64 + bj * 32;
                transpose_item(a.w_in + (size_t)l * D * INW, INW, 64 * kb, v2l(vc0), WIN + (size_t)l * INW * D, D, 32 * pb, 0, scr, lane); continue; }
            r -= I_IN;
            if (r < 3 * I_BR) { const int br = r / I_BR, q = r % I_BR, kb = q / 32, nb = q % 32; const float* W = (br == 0 ? a.w_br_a : br == 1 ? a.w_br_b : a.w_br_c) + (size_t)l * 512 * D;
                transpose_item(W, D, 64 * kb, 32 * nb, WBR + (size_t)l * D * 1536, 1536, 32 * nb, 512 * br, scr, lane); continue; }
            r -= 3 * I_BR;
            { const int kb = r / 32, nb = r % 32; transpose_item(a.w_out + (size_t)l * D * D, D, 64 * kb, 32 * nb, WOUT + (size_t)l * D * D, D, 32 * nb, 0, scr, lane); }
        }
        const int gt = (vcu * NWAVES + wave) * 64 + lane, NGT = NGW * 64;
        for (int i = gt; i < DEPTH * 8 * 128 * 128 / 2; i += NGT) { const float2 v = ((const float2*)a.sg_w)[i]; ((unsigned*)SGW)[i] = pk2(v.x, v.y); }
        for (int i = gt; i < DEPTH * INW; i += NGT) { const int l = i / INW, p = i % INW; BIASV[i] = a.b_in[l * INW + v2l(p)]; }
        for (int m = gw; m < M; m += NGW) ln_row(a.x + (size_t)m * D, a.ln_in_g, a.ln_in_b, H + (size_t)m * D, XN + (size_t)m * D, lane);
    }
    grid.sync();

    for (int l = 0; l < DEPTH; ++l) {
        const bf16* Wl = WIN + (size_t)l * INW * D;
#ifndef NO_P1
        {
            pg8::Gemm g{XN, Wl, M, NMIX, D, D, D}; pg8::StaticOrder S; S.init(M, NMIX, G, bx);
            pg8::EpiIn E{QU, REST, GT, BIASV + l * INW, a.q_norm_g + l * 64, a.k_norm_g + l * 64, 0};
            pg8::gemm_phase<pg8::EpiIn, pg8::StaticOrder, true, true>(lds + RING_OFF, g, S, E);
        }
#endif
        grid.sync();
        {
            const attn_body::AttnTensors AT{(const attn_body::bf16*)(QU + 512), (const attn_body::bf16*)(REST + 1536), (const attn_body::bf16*)(REST + 1664), (const attn_body::bf16*)(REST + 1792), (attn_body::bf16*)(QU + 512)};
#ifndef NO_ATT
            attn_body::attn_phase<8>((char*)lds_raw + RING_OFF, AT, vcu, G);
#endif
            __syncthreads();
#ifndef NO_NA
            for (int U = vcu; U < BATCH * 8 * 4; U += G) na_unit(lds, U >> 5, (U >> 2) & 7, U & 3, QU, REST, a.na_rpb + (size_t)l * 8 * 465);
#endif
            __syncthreads();
#ifndef NO_SG
            for (int U = vcu; U < BATCH * 16 * 2; U += G) sg_unit(lds, U >> 5, (U >> 1) & 15, U & 1, QU, REST, a.sg_ln_g + l * 512, a.sg_ln_b + l * 512, SGW + (size_t)l * 8 * 128 * 128, a.sg_b + l * 8 * 128);
#endif
        }
        grid.sync();
#ifndef NO_P1B
        {
            pg8::Gemm g{XN, Wl + (size_t)NMIX * D, M, NGATE, D, D, D}; pg8::StaticOrder S; S.init(M, NGATE, G, bx);
            pg8::EpiIn E{QU, REST, GT, BIASV + l * INW, a.q_norm_g + l * 64, a.k_norm_g + l * 64, 19};
            pg8::gemm_phase<pg8::EpiIn, pg8::StaticOrder, true, true>(lds + RING_OFF, g, S, E);
        }
#endif
        grid.sync();
#ifndef NO_P3
        {
            pg8::Gemm g{QU, WBR + (size_t)l * D * 1536, M, D, 1536, 1536, 1536}; pg8::StaticOrder S; S.init(M, D, G, bx);
            pg8::EpiMerge E{GT, XN};
            pg8::gemm_phase<pg8::EpiMerge, pg8::StaticOrder, true, true>(lds + RING_OFF, g, S, E);
        }
#endif
        grid.sync();
#ifndef NO_P4
        {
            pg8::Gemm g{XN, WOUT + (size_t)l * D * D, M, D, D, D, D}; pg8::StaticOrder S; S.init(M, D, G, bx);
            pg8::EpiOut E{H, a.b_out + l * D, ALPHA};
            pg8::gemm_phase<pg8::EpiOut, pg8::StaticOrder, true, true>(lds + RING_OFF, g, S, E);
        }
#endif
        grid.sync();
        for (int m = gw; m < M; m += NGW) ln_row(H + (size_t)m * D, a.ln_post_g + l * D, a.ln_post_b + l * D, H + (size_t)m * D, XN + (size_t)m * D, lane);
        if (l + 1 < DEPTH) grid.sync();
    }
}

extern "C" void kernel_launch(void* const* d_in, const int* in_sizes, int n_in, void* d_out, int out_size, void* d_ws, size_t ws_size, hipStream_t stream) {
    static int grid = 0;
    if (grid == 0) {
        if (n_in != 19 || in_sizes[0] != M * D || out_size != M * D || ws_size < WS_END) { fprintf(stderr, "kernel_launch: unexpected shapes (n_in %d, in0 %d, out %d, ws %zu); nothing launched\n", n_in, n_in > 0 ? in_sizes[0] : -1, out_size, ws_size); grid = -1; return; }
        int dev = 0, cus = 0, per_cu = 0;
        if (hipGetDevice(&dev) != hipSuccess || hipDeviceGetAttribute(&cus, hipDeviceAttributeMultiprocessorCount, dev) != hipSuccess) { grid = -1; return; }
        if (hipFuncSetAttribute((const void*)mega_fwd, hipFuncAttributeMaxDynamicSharedMemorySize, LDS_BYTES) != hipSuccess) { fprintf(stderr, "kernel_launch: hipFuncSetAttribute failed\n"); grid = -1; return; }
        if (hipOccupancyMaxActiveBlocksPerMultiprocessor(&per_cu, (const void*)mega_fwd, NWAVES * 64, LDS_BYTES) != hipSuccess || per_cu < 1) { fprintf(stderr, "kernel_launch: occupancy query reports %d\n", per_cu); per_cu = 1; }
        (void)hipGetLastError();
        grid = cus * per_cu;
    }
    if (grid < 0) return;
    Args a{};
    const float** f = (const float**)&a;
    for (int i = 0; i < 19; ++i) f[i] = (const float*)d_in[i];
    a.out = (float*)d_out; a.ws = (unsigned char*)d_ws;
    void* args[] = {&a};
    const hipError_t e = hipLaunchCooperativeKernel((const void*)mega_fwd, dim3(grid), dim3(NWAVES * 64), args, LDS_BYTES, stream);
    if (e != hipSuccess) fprintf(stderr, "kernel_launch: cooperative launch failed: %s (grid %d)\n", hipGetErrorString(e), grid);
}
```

```cpp
#include <hip/hip_runtime.h>
#include <hip/hip_cooperative_groups.h>
#include <cstdio>
#include <cstdint>
namespace cg = cooperative_groups;
namespace pg8 {
#define PG8_LAS __attribute__((address_space(3)))
typedef unsigned short bf16_t;
typedef short bf16x8 __attribute__((ext_vector_type(8)));
typedef float f32x4 __attribute__((ext_vector_type(4)));
typedef unsigned u32x4 __attribute__((ext_vector_type(4)));
constexpr int BM = 256, BK = 64, HALF = 128, HTB = HALF * BK * 2  , STAGE_BYTES = 8 * HTB, NXCD = 8, WGM = 8;

__host__ __device__ __forceinline__ int lds_byte(int r, int c) { const int st = (r >> 4) * 2 + (c >> 5), rr = r & 15, cc = c & 31, ob = rr * 64 + cc * 2; return st * 1024 + (ob ^ (((ob >> 9) & 1) << 5)); }
__host__ __device__ __forceinline__ void stage_rc(int b, int& R, int& C) { const int st = b / 1024, sb = b % 1024, swz = sb ^ (((sb >> 9) & 1) << 5); R = (st >> 1) * 16 + swz / 64; C = (st & 1) * 32 + (swz % 64) / 2; }
__host__ __device__ __forceinline__ int perm32(int rho) { const int n = rho >> 4, i = rho & 15; return 8 * (i >> 2) + 4 * n + (i & 3); }

struct Unit { int pm, pn; };
struct Gemm { const bf16_t* A; const bf16_t* Bt; int M, N, K, lda, ldb; };

struct StaticOrder {
    int nM, nN, nwg, G, c;
    __host__ __device__ void init(int M, int N, int G_, int c_) { nM = M / BM; nN = N / BM; nwg = nM * nN; G = G_; c = c_; }
    __host__ __device__ bool next(int i, Unit& u) const {
        const long L = (long)i * G + c; if (L >= nwg) return false;
        int wgid = (int)L; { const int q = nwg / NXCD, r = nwg % NXCD, xcd = wgid % NXCD, off = wgid / NXCD; wgid = (xcd < r ? xcd * (q + 1) : r * (q + 1) + (xcd - r) * q) + off; }
        const int nig = WGM * nN, gid = wgid / nig, fm = gid * WGM, gsz = (nM - fm) < WGM ? (nM - fm) : WGM;
        u.pm = fm + ((wgid % nig) % gsz); u.pn = (wgid % nig) / gsz; return true;
    }
    __device__ __forceinline__ void a_ready(const Unit&) const {}
    __device__ __forceinline__ void done(const Unit&) const {}
};

__device__ __forceinline__ unsigned cvt_pk_bf16(float lo, float hi) { unsigned r; asm volatile("v_cvt_pk_bf16_f32 %0, %1, %2" : "=v"(r) : "v"(lo), "v"(hi)); return r; }
__device__ __forceinline__ float bf_lo(unsigned w) { return __uint_as_float(w << 16); }
__device__ __forceinline__ float bf_hi(unsigned w) { return __uint_as_float(w & 0xffff0000u); }
constexpr float LOG2E = 1.4426950408889634f;
constexpr float C2 = 0.125f * LOG2E;
__device__ __forceinline__ float sigmoid_f(float x) { return __builtin_amdgcn_rcpf(1.0f + __builtin_amdgcn_exp2f(-x * LOG2E)); }

struct EpiIn {
    static constexpr bool PERM = true, AFTER_DRAIN = false, MIDHOOK = false;
    bf16_t* QU; bf16_t* REST; bf16_t* G; const float* biasv; const float* qg; const float* kg; int vt0;
    __device__ __forceinline__ void operator()(const f32x4 (&acc)[2][2][4][2], const Unit& u, int wr, int wc, int fr, int fq) const {
        const int vt = u.pn + vt0;
        const int vc0 = vt * 256 + wc * 64 + fq * 8;
        bf16_t* dst; int pitch, dcol;
        if (vt < 6) { dst = QU; pitch = 1536; dcol = vc0; } else if (vt < 19) { dst = REST; pitch = 3328; dcol = vc0 - 1536; } else { dst = G; pitch = 3072; dcol = vc0 - 4864; }
        int type = 0; float sc = 1.f; const float* ng = qg;
        if (vt < 2) sc = C2;
        else if (vt < 4) { type = 3; sc = C2; }
        else if (vt == 10 || vt == 11 || vt == 13 || vt == 14 || vt == 17 || vt == 18) type = 1;
        else if (vt == 12) { if (wc < 2) { type = 3; ng = kg; } }
        else if (vt >= 19) type = 2;
        f32x4 bv[2][2];
#pragma unroll
        for (int bj = 0; bj < 2; ++bj)
#pragma unroll
            for (int n = 0; n < 2; ++n) bv[bj][n] = *(const f32x4*)(biasv + vc0 + bj * 32 + 4 * n);
        const int row0 = u.pm * BM + wr * 64 + fr;
        if (type == 3) {
#pragma unroll
            for (int ai = 0; ai < 2; ++ai)
#pragma unroll
                for (int m = 0; m < 4; ++m) {
                    asm volatile("" ::: "memory");
                    int fqo = fq; asm volatile("" : "+v"(fqo));
                    const float* bp = biasv + vt * 256 + wc * 64 + fqo * 8; const float* gp = ng + fqo * 8;
                    const int row = row0 + ai * HALF + m * 16; const int s = row & 2047; const float pr = (float)(s >> 6), pc = (float)(s & 63);
                    float ss = 0.f;
#pragma unroll
                    for (int bj = 0; bj < 2; ++bj)
#pragma unroll
                        for (int n = 0; n < 2; ++n) { const f32x4 v = acc[ai][bj][m][n] + *(const f32x4*)(bp + bj * 32 + 4 * n); ss += (v[0] * v[0] + v[1] * v[1]) + (v[2] * v[2] + v[3] * v[3]); }
                    ss += __shfl_xor(ss, 16); ss += __shfl_xor(ss, 32);
                    const float rs = __builtin_amdgcn_rsqf(ss * (1.0f / 64.0f) + 1e-6f);
                    bf16_t* rowp = dst + (size_t)row * pitch + dcol;
#pragma unroll
                    for (int bj = 0; bj < 2; ++bj) { const float pos = bj ? pc : pr; u32x4 w;
#pragma unroll
                        for (int n = 0; n < 2; ++n) { const f32x4 v = (acc[ai][bj][m][n] + *(const f32x4*)(bp + bj * 32 + 4 * n)) * rs * *(const f32x4*)(gp + bj * 32 + 4 * n);
#pragma unroll
                            for (int h = 0; h < 2; ++h) { const float fr_ = __builtin_amdgcn_exp2f(-(float)(4 * fqo + 2 * n + h) * 0.8304820237218407f) * 0.15915494309189535f;
                                const float ang = pos * fr_; const float c = __builtin_amdgcn_cosf(ang), sn = __builtin_amdgcn_sinf(ang);
                                w[2 * n + h] = cvt_pk_bf16((v[2 * h] * c - v[2 * h + 1] * sn) * sc, (v[2 * h] * sn + v[2 * h + 1] * c) * sc); } }
                        *(u32x4*)(rowp + bj * 32) = w; }
                    __builtin_amdgcn_sched_barrier(0);
                }
        } else {
#pragma unroll
            for (int ai = 0; ai < 2; ++ai)
#pragma unroll
                for (int m = 0; m < 4; ++m) { bf16_t* rowp = dst + (size_t)(row0 + ai * HALF + m * 16) * pitch + dcol;
#pragma unroll
                    for (int bj = 0; bj < 2; ++bj) { f32x4 v0 = acc[ai][bj][m][0] + bv[bj][0], v1 = acc[ai][bj][m][1] + bv[bj][1];
                        if (type == 1) {
#pragma unroll
                            for (int e = 0; e < 4; ++e) { v0[e] *= sigmoid_f(v0[e]); v1[e] *= sigmoid_f(v1[e]); } }
                        else if (type == 2) {
#pragma unroll
                            for (int e = 0; e < 4; ++e) { v0[e] = fmaxf(sigmoid_f(v0[e]), 1e-30f); v1[e] = fmaxf(sigmoid_f(v1[e]), 1e-30f); } }
                        else { v0 = v0 * sc; v1 = v1 * sc; }
                        u32x4 w; w.x = cvt_pk_bf16(v0[0], v0[1]); w.y = cvt_pk_bf16(v0[2], v0[3]); w.z = cvt_pk_bf16(v1[0], v1[1]); w.w = cvt_pk_bf16(v1[2], v1[3]);
                        *(u32x4*)(rowp + bj * 32) = w; } }
        }
    }
};

struct EpiMerge {
    static constexpr bool PERM = true, AFTER_DRAIN = false, MIDHOOK = true;
    const bf16_t* G; bf16_t* O;
    __device__ __forceinline__ void mid(f32x4 (&acc)[2][2][4][2], const Unit& u, int seg, int wr, int wc, int fr, int fq) const {
        const int row0 = u.pm * BM + wr * 64 + fr, col0 = u.pn * BM + wc * 32 + 8 * fq;
        const bf16_t* gp = G + (size_t)row0 * 3072 + (seg - 1) * 1024 + col0;
#pragma unroll
        for (int ai = 0; ai < 2; ++ai)
#pragma unroll
            for (int m = 0; m < 4; ++m)
#pragma unroll
                for (int bj = 0; bj < 2; ++bj) { const bf16_t* p = gp + (size_t)(ai * HALF + m * 16) * 3072 + bj * HALF;
                    const u32x4 ga = *(const u32x4*)p, gb = *(const u32x4*)(p + 1024);
#pragma unroll
                    for (int e = 0; e < 2; ++e) {
                        acc[ai][bj][m][0][2 * e] *= bf_lo(ga[e]) * __builtin_amdgcn_rcpf(bf_lo(gb[e])); acc[ai][bj][m][0][2 * e + 1] *= bf_hi(ga[e]) * __builtin_amdgcn_rcpf(bf_hi(gb[e]));
                        acc[ai][bj][m][1][2 * e] *= bf_lo(ga[2 + e]) * __builtin_amdgcn_rcpf(bf_lo(gb[2 + e])); acc[ai][bj][m][1][2 * e + 1] *= bf_hi(ga[2 + e]) * __builtin_amdgcn_rcpf(bf_hi(gb[2 + e])); } }
    }
    __device__ __forceinline__ void operator()(const f32x4 (&acc)[2][2][4][2], const Unit& u, int wr, int wc, int fr, int fq) const {
        const int row0 = u.pm * BM + wr * 64 + fr, col0 = u.pn * BM + wc * 32 + 8 * fq;
#pragma unroll
        for (int ai = 0; ai < 2; ++ai)
#pragma unroll
            for (int m = 0; m < 4; ++m)
#pragma unroll
                for (int bj = 0; bj < 2; ++bj) { const size_t r = (size_t)(row0 + ai * HALF + m * 16);
                    const u32x4 g2 = *(const u32x4*)(G + r * 3072 + 2048 + col0 + bj * HALF);
                    const f32x4 a0 = acc[ai][bj][m][0], a1 = acc[ai][bj][m][1]; u32x4 w;
                    w.x = cvt_pk_bf16(a0[0] * bf_lo(g2.x), a0[1] * bf_hi(g2.x)); w.y = cvt_pk_bf16(a0[2] * bf_lo(g2.y), a0[3] * bf_hi(g2.y));
                    w.z = cvt_pk_bf16(a1[0] * bf_lo(g2.z), a1[1] * bf_hi(g2.z)); w.w = cvt_pk_bf16(a1[2] * bf_lo(g2.w), a1[3] * bf_hi(g2.w));
                    *(u32x4*)(O + r * 1024 + col0 + bj * HALF) = w; }
    }
};

struct EpiOut {
    static constexpr bool PERM = false, AFTER_DRAIN = false, MIDHOOK = false;
    float* H; const float* bias; float alpha; bool wr_en;
    __device__ __forceinline__ void operator()(const f32x4 (&acc)[2][2][4][2], const Unit& u, int wr, int wc, int fr, int fq) const {
        const int row0 = u.pm * BM + wr * 64 + fr, col0 = u.pn * BM + wc * 32 + 4 * fq;
        f32x4 bv[2][2];
#pragma unroll
        for (int bj = 0; bj < 2; ++bj)
#pragma unroll
            for (int n = 0; n < 2; ++n) bv[bj][n] = *(const f32x4*)(bias + col0 + bj * HALF + n * 16);
#pragma unroll
        for (int ai = 0; ai < 2; ++ai)
#pragma unroll
            for (int m = 0; m < 4; ++m) { float* rowp = H + (size_t)(row0 + ai * HALF + m * 16) * 1024 + col0;
#pragma unroll
                for (int bj = 0; bj < 2; ++bj)
#pragma unroll
                    for (int n = 0; n < 2; ++n) { float* p = rowp + bj * HALF + n * 16; const f32x4 hv = *(const f32x4*)p; const f32x4 r_ = hv * alpha + acc[ai][bj][m][n] + bv[bj][n]; if (wr_en) *(f32x4*)p = r_; } }
    }
};
template <class Epi, class Sched, bool ALIGN_EPI = false, bool SP2 = false>
__device__ __forceinline__ void gemm_phase(PG8_LAS unsigned char* lds, const Gemm g, const Sched& S, const Epi& E) {
    int tid_ = threadIdx.x; asm volatile("" : "+v"(tid_));
    const int tid = tid_, wid = __builtin_amdgcn_readfirstlane(tid >> 6), lane = tid & 63, wr = wid >> 2, wc = wid & 3, fr = lane & 15, fq = lane >> 4;
    const int K = g.K, nt = K / BK;
    unsigned voffA[2], voffB[2];
#pragma unroll
    for (int i = 0; i < 2; ++i) { int R, C; stage_rc(tid * 16 + i * 8192, R, C); const int Rb = Epi::PERM ? ((R & ~31) + perm32(R & 31)) : R;
        voffA[i] = (unsigned)(R * g.lda + C) * 2u; voffB[i] = (unsigned)(Rb * g.ldb + C) * 2u; }
    const size_t kstep = (size_t)(BK * 2);
    const size_t hstepA = (size_t)HALF * g.lda * 2, hstepB = (size_t)HALF * g.ldb * 2;
    const size_t tstepA = 2 * hstepA, tstepB = 2 * hstepB;
    const unsigned ldsw = (unsigned)wid * 1024u;
    const int aoff = lds_byte(wr * 64 + fr, fq * 8), boff = lds_byte(wc * 32 + fr, fq * 8);
#define PG8_SA(b, h) (((b) * 2 + (h)) * HTB)
#define PG8_SB(b, h) ((4 + (b) * 2 + (h)) * HTB)
#define PG8_STAGE(bufoff, gbase, voff) do { _Pragma("unroll") for (int _i = 0; _i < 2; ++_i) \
        __builtin_amdgcn_global_load_lds((const unsigned*)((const char*)(gbase) + (voff)[_i]), (PG8_LAS unsigned*)(lds + (bufoff) + ldsw + _i * 8192), 16, 0, 0); } while (0)
#define PG8_LDA(dst, b, h) do { _Pragma("unroll") for (int m = 0; m < 4; ++m) _Pragma("unroll") for (int k = 0; k < 2; ++k) dst[m][k] = *(const PG8_LAS bf16x8*)(lds + PG8_SA(b, h) + aoff + m * 2048 + k * 1024); } while (0)
#define PG8_LDB(dst, b, h) do { _Pragma("unroll") for (int n = 0; n < 2; ++n) _Pragma("unroll") for (int k = 0; k < 2; ++k) dst[n][k] = *(const PG8_LAS bf16x8*)(lds + PG8_SB(b, h) + boff + n * 2048 + k * 1024); } while (0)
#define PG8_MMA(ai, bj, At, Bt) do { __builtin_amdgcn_s_setprio(1); _Pragma("unroll") for (int m = 0; m < 4; ++m) _Pragma("unroll") for (int n = 0; n < 2; ++n) _Pragma("unroll") for (int k = 0; k < 2; ++k) \
        acc[ai][bj][m][n] = __builtin_amdgcn_mfma_f32_16x16x32_bf16(Bt[n][k], At[m][k], acc[ai][bj][m][n], 0, 0, 0); __builtin_amdgcn_s_setprio(0); } while (0)
#define PG8_WAIT_V(n) asm volatile("s_waitcnt vmcnt(" #n ")" ::: "memory")
#define PG8_WAIT_L(n) asm volatile("s_waitcnt lgkmcnt(" #n ")" ::: "memory")
#define PG8_BAR __builtin_amdgcn_s_barrier()
#define PG8_SCHED __builtin_amdgcn_sched_barrier(0)
    Unit cur, nxt; int ui = 0;
    if (!S.next(0, cur)) return;
    f32x4 acc[2][2][4][2];
#pragma unroll
    for (int a = 0; a < 2; ++a)
#pragma unroll
        for (int b = 0; b < 2; ++b)
#pragma unroll
            for (int m = 0; m < 4; ++m)
#pragma unroll
                for (int n = 0; n < 2; ++n) acc[a][b][m][n] = (f32x4){0.f, 0.f, 0.f, 0.f};
    bf16x8 At[4][2], B0[2][2], B1[2][2];
    const char* cA = (const char*)g.A + (size_t)cur.pm * tstepA; const char* cB = (const char*)g.Bt + (size_t)cur.pn * tstepB;
    S.a_ready(cur);
    if constexpr (SP2) {
        PG8_STAGE(PG8_SB(0, 0), cB, voffB); PG8_STAGE(PG8_SB(0, 1), cB + hstepB, voffB); PG8_STAGE(PG8_SA(0, 0), cA, voffA); PG8_STAGE(PG8_SA(0, 1), cA + hstepA, voffA);
        if (wr == 1) PG8_BAR;
        PG8_WAIT_V(2); PG8_BAR;
        PG8_STAGE(PG8_SB(1, 0), cB + kstep, voffB); PG8_STAGE(PG8_SA(1, 0), cA + kstep, voffA); PG8_STAGE(PG8_SB(1, 1), cB + hstepB + kstep, voffB);
        PG8_WAIT_V(6); PG8_BAR;
    } else {
        PG8_STAGE(PG8_SB(0, 0), cB, voffB); PG8_STAGE(PG8_SA(0, 0), cA, voffA); PG8_STAGE(PG8_SB(0, 1), cB + hstepB, voffB); PG8_STAGE(PG8_SA(0, 1), cA + hstepA, voffA);
        if (wr == 1) PG8_BAR;
        PG8_WAIT_V(4); PG8_BAR;
        PG8_STAGE(PG8_SB(1, 0), cB + kstep, voffB); PG8_STAGE(PG8_SA(1, 0), cA + kstep, voffA); PG8_STAGE(PG8_SB(1, 1), cB + hstepB + kstep, voffB);
        PG8_WAIT_V(6); PG8_BAR;
    }
    for (;;) {
        const bool has_next = S.next(ui + 1, nxt);
        const char* nA = has_next ? (const char*)g.A + (size_t)nxt.pm * tstepA : cA; const char* nB = has_next ? (const char*)g.Bt + (size_t)nxt.pn * tstepB : cB;
        for (int t = 0; t < nt; t += 2) {
            const bool last = (t == nt - 2);
            const char* a1 = cA + (size_t)(t + 1) * kstep;
            const char* a2 = last ? nA : cA + (size_t)(t + 2) * kstep; const char* b2 = last ? nB : cB + (size_t)(t + 2) * kstep;
            const char* a3 = a2 + kstep; const char* b3 = b2 + kstep;
            if (last && has_next) S.a_ready(nxt);
            if constexpr (Epi::MIDHOOK) { if (t == 8 || t == 16) E.mid(acc, cur, t >> 3, wr, wc, fr, fq); }
            if constexpr (SP2) {
            PG8_LDB(B0, 0, 0); PG8_LDB(B1, 0, 1); PG8_SCHED; PG8_LDA(At, 0, 0); PG8_STAGE(PG8_SA(1, 1), a1 + hstepA, voffA);
            PG8_WAIT_V(8); PG8_WAIT_L(0); PG8_BAR; PG8_MMA(0, 0, At, B0); PG8_MMA(0, 1, At, B1); PG8_BAR; PG8_SCHED;
            PG8_LDA(At, 0, 1); PG8_STAGE(PG8_SB(0, 0), b2, voffB); PG8_STAGE(PG8_SB(0, 1), b2 + hstepB, voffB); PG8_STAGE(PG8_SA(0, 0), a2, voffA);
            PG8_WAIT_V(8); PG8_WAIT_L(0); PG8_BAR; PG8_MMA(1, 0, At, B0); PG8_MMA(1, 1, At, B1); PG8_BAR; PG8_SCHED;
            PG8_LDB(B0, 1, 0); PG8_LDB(B1, 1, 1); PG8_SCHED; PG8_LDA(At, 1, 0); PG8_STAGE(PG8_SA(0, 1), a2 + hstepA, voffA);
            PG8_WAIT_V(8); PG8_WAIT_L(0); PG8_BAR; PG8_MMA(0, 0, At, B0); PG8_MMA(0, 1, At, B1); PG8_BAR; PG8_SCHED;
            PG8_LDA(At, 1, 1); PG8_STAGE(PG8_SB(1, 0), b3, voffB); PG8_STAGE(PG8_SB(1, 1), b3 + hstepB, voffB); PG8_STAGE(PG8_SA(1, 0), a3, voffA);
            PG8_WAIT_V(8); PG8_WAIT_L(0); PG8_BAR; PG8_MMA(1, 0, At, B0); PG8_MMA(1, 1, At, B1); PG8_BAR; PG8_SCHED;
            } else {
            PG8_LDB(B0, 0, 0); PG8_SCHED; PG8_LDA(At, 0, 0); PG8_STAGE(PG8_SA(1, 1), a1 + hstepA, voffA);
            PG8_WAIT_L(8); PG8_BAR; PG8_WAIT_L(0); PG8_MMA(0, 0, At, B0); PG8_BAR; PG8_SCHED;
            PG8_LDB(B1, 0, 1); PG8_STAGE(PG8_SB(0, 0), b2, voffB);
            PG8_BAR; PG8_WAIT_L(0); PG8_MMA(0, 1, At, B1); PG8_BAR;
            PG8_LDA(At, 0, 1); PG8_STAGE(PG8_SA(0, 0), a2, voffA);
            PG8_BAR; PG8_WAIT_L(0); PG8_MMA(1, 0, At, B0); PG8_BAR; PG8_SCHED;
            PG8_STAGE(PG8_SB(0, 1), b2 + hstepB, voffB);
            PG8_WAIT_V(6); PG8_BAR; PG8_MMA(1, 1, At, B1); PG8_BAR;
            PG8_LDB(B0, 1, 0); PG8_SCHED; PG8_LDA(At, 1, 0); PG8_STAGE(PG8_SA(0, 1), a2 + hstepA, voffA);
            PG8_WAIT_L(8); PG8_BAR; PG8_WAIT_L(0); PG8_MMA(0, 0, At, B0); PG8_BAR; PG8_SCHED;
            PG8_LDB(B1, 1, 1); PG8_STAGE(PG8_SB(1, 0), b3, voffB);
            PG8_BAR; PG8_WAIT_L(0); PG8_MMA(0, 1, At, B1); PG8_BAR;
            PG8_LDA(At, 1, 1); PG8_STAGE(PG8_SA(1, 0), a3, voffA);
            PG8_BAR; PG8_WAIT_L(0); PG8_MMA(1, 0, At, B0); PG8_BAR; PG8_SCHED;
            PG8_STAGE(PG8_SB(1, 1), b3 + hstepB, voffB);
            PG8_WAIT_V(6); PG8_BAR; PG8_MMA(1, 1, At, B1); PG8_BAR;
            }
        }
        if constexpr (ALIGN_EPI) { if (wr == 0) PG8_BAR; }
        if constexpr (!Epi::AFTER_DRAIN) { E(acc, cur, wr, wc, fr, fq); S.done(cur); }
        if (!has_next) break;
#pragma unroll
        for (int a = 0; a < 2; ++a)
#pragma unroll
            for (int b = 0; b < 2; ++b)
#pragma unroll
                for (int m = 0; m < 4; ++m)
#pragma unroll
                    for (int n = 0; n < 2; ++n) acc[a][b][m][n] = (f32x4){0.f, 0.f, 0.f, 0.f};
        cur = nxt; cA = nA; cB = nB; ++ui;
        if constexpr (ALIGN_EPI) { if (wr == 1) PG8_BAR; }
    }
    PG8_WAIT_V(0);
    if constexpr (!ALIGN_EPI) { if (wr == 0) PG8_BAR; }
    PG8_BAR;
    if constexpr (Epi::AFTER_DRAIN) { E.fused(acc, cur, wr, wc, fr, fq, lds, wid, lane); S.done(cur); }
#undef PG8_SA
#undef PG8_SB
#undef PG8_STAGE
#undef PG8_LDA
#undef PG8_LDB
#undef PG8_MMA
#undef PG8_WAIT_V
#undef PG8_WAIT_L
#undef PG8_BAR
#undef PG8_SCHED
}
}
#include <hip/hip_bf16.h>
#include <cmath>
namespace attn_body {
using bf16=__hip_bfloat16;
using bf16x8=__attribute__((ext_vector_type(8)))short;
using s16x4=__attribute__((ext_vector_type(4)))short;
using f32x16=__attribute__((ext_vector_type(16)))float;
using u32x4=__attribute__((ext_vector_type(4)))unsigned;
constexpr int BATCH=8,NHEAD=8,SEQ=2048,D=64,QP=1536,KP=3328;
constexpr int NW=8,QBLK=32,QB=QBLK*NW,KVBLK=64,NQB=SEQ/QB;
constexpr int ATTN_UNIT_ROWS=QB;
__device__ __forceinline__ int crow(int r,int hi){return (r&3)+8*(r>>2)+4*hi;}
#define SBAR() __builtin_amdgcn_sched_barrier(0)
__device__ __forceinline__ void cmask(f32x16&p0,f32x16&p1,int jb,int qrel,int hi){
  const float NEG=-INFINITY; int kb=64*jb+4*hi;
  #pragma unroll
  for(int r=0;r<16;++r){int kv=kb+(r&3)+8*(r>>2); if(kv>qrel)p0[r]=NEG; if(kv+32>qrel)p1[r]=NEG;}
}

constexpr int NSLOT=3, SLOTB=8192;
constexpr int LDS_K=0, LDS_V=NSLOT*SLOTB, LDS_WS=2*NSLOT*SLOTB, LDS_OST=LDS_WS+NW*64*4, LDS_BYTES=LDS_OST+NW*4096;
constexpr float C2=0.125f*1.4426950408889634f;
__device__ __forceinline__ void glds16(const void*gsrc,unsigned lds_dst){unsigned keep;
  asm volatile("s_mov_b32 %0, m0\n\ts_mov_b32 m0, %2\n\ts_nop 0\n\tglobal_load_lds_dwordx4 %1, off\n\ts_mov_b32 m0, %0":"=&s"(keep):"v"(gsrc),"s"(lds_dst):"memory");}
__device__ __forceinline__ float max3f(float a,float b,float c){float r;asm("v_max3_f32 %0, %1, %2, %3":"=v"(r):"v"(a),"v"(b),"v"(c));return r;}
__device__ __forceinline__ float max2f(float a,float b){float r;asm("v_max_f32_e32 %0, %1, %2":"=v"(r):"v"(a),"v"(b));return r;}
__device__ __forceinline__ float fadd_s(float a,float b){float r;asm("v_add_f32_e32 %0, %1, %2":"=v"(r):"v"(a),"v"(b));return r;}
__device__ __forceinline__ float fsub_s(float a,float b){float r;asm("v_sub_f32_e32 %0, %1, %2":"=v"(r):"v"(a),"v"(b));return r;}
typedef float f32x2_t __attribute__((ext_vector_type(2))); typedef __bf16 bf16x2_t __attribute__((ext_vector_type(2)));
__device__ __forceinline__ unsigned cvtpk_s(float lo,float hi){f32x2_t v={lo,hi};bf16x2_t b=__builtin_convertvector(v,bf16x2_t);return __builtin_bit_cast(unsigned,b);}
#define WAIT_BAR(N) asm volatile("s_waitcnt vmcnt(" #N ") lgkmcnt(0)\n\ts_barrier":::"memory")

__device__ __forceinline__ void qkt(f32x16&p0,f32x16&p1,const char*Kslot,const bf16x8*qr,const f32x16&negm,int r32,int hi){
  const char*kb=Kslot+hi*1024+r32*16;
  #pragma unroll
  for(int d0=0;d0<4;++d0){
    const bf16x8 b0=*reinterpret_cast<const bf16x8*>(kb+d0*2048);
    const bf16x8 b1=*reinterpret_cast<const bf16x8*>(kb+d0*2048+512);
    if(d0==0){p0=__builtin_amdgcn_mfma_f32_32x32x16_bf16(b0,qr[0],negm,0,0,0);p1=__builtin_amdgcn_mfma_f32_32x32x16_bf16(b1,qr[0],negm,0,0,0);}
    else{p0=__builtin_amdgcn_mfma_f32_32x32x16_bf16(b0,qr[d0],p0,0,0,0);p1=__builtin_amdgcn_mfma_f32_32x32x16_bf16(b1,qr[d0],p1,0,0,0);}}
}
typedef __attribute__((address_space(3))) const char* lds_cptr;
typedef short v4i16_t __attribute__((ext_vector_type(4)));
__device__ __forceinline__ void kload8(bf16x8*kf,lds_cptr kp){
  kf[0]=*(const __attribute__((address_space(3))) bf16x8*)(kp);      kf[1]=*(const __attribute__((address_space(3))) bf16x8*)(kp+512);
  kf[2]=*(const __attribute__((address_space(3))) bf16x8*)(kp+2048); kf[3]=*(const __attribute__((address_space(3))) bf16x8*)(kp+2560);
  kf[4]=*(const __attribute__((address_space(3))) bf16x8*)(kp+4096); kf[5]=*(const __attribute__((address_space(3))) bf16x8*)(kp+4608);
  kf[6]=*(const __attribute__((address_space(3))) bf16x8*)(kp+6144); kf[7]=*(const __attribute__((address_space(3))) bf16x8*)(kp+6656);
}
__device__ __forceinline__ void kload2(bf16x8*kf,lds_cptr kp,int j){ kf[2*j]=*(const __attribute__((address_space(3))) bf16x8*)(kp+j*2048); kf[2*j+1]=*(const __attribute__((address_space(3))) bf16x8*)(kp+j*2048+512); }
__device__ __forceinline__ s16x4 vtr(lds_cptr p){ return __builtin_bit_cast(s16x4,__builtin_amdgcn_ds_read_tr16_b64_v4i16((__attribute__((address_space(3))) v4i16_t*)p)); }
__device__ __forceinline__ float rowmax(const f32x16&p0,const f32x16&p1){
  float a=max3f(p0[0],p0[1],p1[0]),b=max3f(p0[2],p0[3],p1[1]);a=max3f(a,p1[2],p1[3]);
  #pragma unroll
  for(int r=4;r<16;r+=4){a=max3f(a,p0[r],p0[r+1]);b=max3f(b,p0[r+2],p0[r+3]);a=max3f(a,p1[r],p1[r+1]);b=max3f(b,p1[r+2],p1[r+3]);}
  const float m=max2f(a,b);
  auto rr=__builtin_amdgcn_permlane32_swap(__float_as_uint(m),__float_as_uint(m),false,false);
  return max2f(__uint_as_float(rr[0]),__uint_as_float(rr[1]));
}
__device__ __forceinline__ void pv(f32x16*o,int vb,bf16x8 pa0,bf16x8 pa1,bf16x8 pa2,bf16x8 pa3){
  #pragma unroll
  for(int d0=0;d0<2;++d0){s16x4 lo[4],hi[4];
    #pragma unroll
    for(int ks=0;ks<4;++ks){
      asm volatile("ds_read_b64_tr_b16 %0,%1 offset:%c2":"=&v"(lo[ks]):"v"(vb),"i"(d0*4096+ks*1024):"memory");
      asm volatile("ds_read_b64_tr_b16 %0,%1 offset:%c2":"=&v"(hi[ks]):"v"(vb),"i"(d0*4096+ks*1024+512):"memory");}
    asm volatile("s_waitcnt lgkmcnt(0)":::"memory");SBAR();
    #define PK(k) (bf16x8){lo[k][0],lo[k][1],lo[k][2],lo[k][3],hi[k][0],hi[k][1],hi[k][2],hi[k][3]}
    o[d0]=__builtin_amdgcn_mfma_f32_32x32x16_bf16(pa0,PK(0),o[d0],0,0,0);
    o[d0]=__builtin_amdgcn_mfma_f32_32x32x16_bf16(pa1,PK(1),o[d0],0,0,0);
    o[d0]=__builtin_amdgcn_mfma_f32_32x32x16_bf16(pa2,PK(2),o[d0],0,0,0);
    o[d0]=__builtin_amdgcn_mfma_f32_32x32x16_bf16(pa3,PK(3),o[d0],0,0,0);
    #undef PK
  }
}

#ifndef ATTN_STORE16
#define ATTN_STORE16(p,v) (*(u32x4*)(p)=(v))
#endif
template<int THRL> __device__ __forceinline__ void attn_unit(int b,int h,int kvh,int qb,const bf16*Q,const bf16*__restrict__ K,const bf16*__restrict__ V,const bf16*__restrict__ Z,bf16*O,char*shm,bool wr_en){
  int tid_=threadIdx.x; asm volatile("":"+v"(tid_)); const int tid=tid_,lane=tid&63,r32=lane&31,hi=lane>>5; const int wid=__builtin_amdgcn_readfirstlane(tid>>6);
  const long rowbase=(long)b*SEQ; const int q0=qb*QB;
  const bf16*Qw=Q+(rowbase+q0+wid*QBLK)*QP+h*D;
  const bf16*Kh=K+rowbase*KP+kvh*D,*Vh=V+rowbase*KP+kvh*D;
  const unsigned lds0=(unsigned)(uintptr_t)shm;
  float*wsf=(float*)(shm+LDS_WS)+wid*64;
  const bf16*ksrc=Kh+(long)lane*KP+wid*8;
  const bf16*vsrc=Vh+(long)(16*(wid&3)+(lane>>2))*KP+(wid>>2)*32+(lane&3)*8;
  const unsigned kdst=lds0+LDS_K+wid*1024, vdst=lds0+LDS_V+wid*1024;
  #define DMA_K(t,slot) glds16(ksrc+(long)(t)*KVBLK*KP,(unsigned)__builtin_amdgcn_readfirstlane(kdst+(slot)))
  #define DMA_V(t,slot) glds16(vsrc+(long)(t)*KVBLK*KP,(unsigned)__builtin_amdgcn_readfirstlane(vdst+(slot)))
  const int vb0=(int)(lds0+LDS_V)+((lane>>4)&1)*32+(lane&3)*8+(4*hi+((lane&15)>>2))*64;
  const char*Kbase=shm+LDS_K; bf16x8 kf[8];
  const lds_cptr shm3=(lds_cptr)shm; const lds_cptr kp0=shm3+LDS_K+hi*1024+r32*16; const lds_cptr vp0=shm3+LDS_V+((lane>>4)&1)*32+(lane&3)*8+(4*hi+((lane&15)>>2))*64;
  const int NT=SEQ/KVBLK;
  DMA_K(0,0);DMA_V(0,0);DMA_K(1,SLOTB);
  bf16x8 qr[4];
  #pragma unroll
  for(int d0=0;d0<4;++d0)qr[d0]=*reinterpret_cast<const bf16x8*>(&Qw[(long)r32*QP+d0*16+hi*8]);
  float mhat=0.f,l_reg=0.f;f32x16 o[2];o[0]=f32x16{};o[1]=f32x16{};f32x16 negm=f32x16{};asm volatile("":"+v"(negm));

  #define CMASK(P0,P1,t) do{}while(0)
  bool resc=false;
  #define START(P0,P1) do{ const float rm=rowmax(P0,P1); resc=false; \
    { const float dl=rm; mhat=fadd_s(mhat,dl); \
      _Pragma("unroll") for(int r=0;r<16;++r){P0[r]=fsub_s(P0[r],dl);P1[r]=fsub_s(P1[r],dl);} \
      _Pragma("unroll") for(int r=0;r<16;++r)negm[r]=-mhat; asm volatile("":"+v"(negm)); } \
    _Pragma("unroll") for(int r=0;r<16;++r)P0[r]=__builtin_amdgcn_exp2f(P0[r]); }while(0)
  #define RESC() do{ if(resc){ asm volatile("s_waitcnt lgkmcnt(0)":::"memory"); \
      _Pragma("unroll") for(int d_=0;d_<2;++d_) _Pragma("unroll") for(int r=0;r<16;++r)o[d_][r]*=wsf[crow(r,hi)]; } }while(0)
  f32x16 pA0,pA1,pB0,pB1;
  int sl_prev=0,sl_cur=0,sl_next=SLOTB;
  #define ROT() do{sl_prev=sl_cur;sl_cur=sl_next;sl_next=(sl_next==(NSLOT-1)*SLOTB)?0:sl_next+SLOTB;}while(0)
  DMA_K(2,2*SLOTB);
  WAIT_BAR(3);
  qkt(pA0,pA1,Kbase,qr,negm,r32,hi);asm volatile("s_nop 15\n\ts_nop 7":"+v"(pA0),"+v"(pA1));CMASK(pA0,pA1,0);
  START(pA0,pA1);
  _Pragma("unroll") for(int r=0;r<16;++r)pA1[r]=__builtin_amdgcn_exp2f(pA1[r]);
  WAIT_BAR(0);
  DMA_K(3,0);DMA_V(1,SLOTB);
  ROT();
  kload8(kf,kp0+sl_cur);
  WAIT_BAR(2);
  s16x4 vlo[8],vhi[8]; u32x4 pw0,pw1,pw2,pw3;
  #define PKW(P,B) cvtpk_s(P[B],P[B+1])
  #define PAF(k) __builtin_bit_cast(bf16x8,pw##k)
  #define VFR(i) (bf16x8){vlo[i][0],vlo[i][1],vlo[i][2],vlo[i][3],vhi[i][0],vhi[i][1],vhi[i][2],vhi[i][3]}
  #define PIN(x) asm volatile("":"+v"(x))
  #define MX3(a,b,c) __builtin_fmaxf(__builtin_fmaxf((a),(b)),(c))
  #define GAPA(MF,A0,A1,A2,A3,W0,W1,PW) do{ MF; sacc+=A0; sacc+=A1; sacc+=A2; sacc+=A3; PIN(sacc); W0; W1; PIN(PW); SBAR(); }while(0)
  #define EX(v) __builtin_amdgcn_exp2f(v)
  #define GAPB(MF,X,B) do{ MF; X[B]=EX(X[B]); X[B+1]=EX(X[B+1]); X[B+2]=EX(X[B+2]); X[B+3]=EX(X[B+3]); PIN(X); SBAR(); }while(0)
  #define VRD(i) do{ vlo[i]=vtr(vp_+(((i)>>2)*4096+((i)&3)*1024)); vhi[i]=vtr(vp_+(((i)>>2)*4096+((i)&3)*1024+512)); }while(0)
  #define KRD(G,j) do{ if(G){ kload2(kf,kp0+sl_next,j); SBAR(); } }while(0)
  #define STEP(C0,C1,P0,P1,t,GK,GV,GL) do{ SBAR(); \
    const lds_cptr vp_=vp0+sl_prev; \
    VRD(0); SBAR(); float sacc=(P0[0]+P0[1]); \
    GAPA(C0=__builtin_amdgcn_mfma_f32_32x32x16_bf16(kf[0],qr[0],negm,0,0,0), P0[2],P0[3],P0[4],P0[5],     pw0[0]=PKW(P0,0), pw0[1]=PKW(P0,2), pw0); \
    VRD(4); SBAR(); GAPA(C1=__builtin_amdgcn_mfma_f32_32x32x16_bf16(kf[1],qr[0],negm,0,0,0), P0[6],P0[7],P0[8],P0[9],     pw0[2]=PKW(P0,4), pw0[3]=PKW(P0,6), pw0); \
    VRD(1); SBAR(); GAPA(C0=__builtin_amdgcn_mfma_f32_32x32x16_bf16(kf[2],qr[1],C0,0,0,0),   P0[10],P0[11],P0[12],P0[13], pw1[0]=PKW(P0,8), pw1[1]=PKW(P0,10), pw1); \
    VRD(5); SBAR(); GAPA(C1=__builtin_amdgcn_mfma_f32_32x32x16_bf16(kf[3],qr[1],C1,0,0,0),   P0[14],P0[15],P1[0],P1[1],   pw1[2]=PKW(P0,12),pw1[3]=PKW(P0,14), pw1); \
    VRD(2); SBAR(); GAPA(C0=__builtin_amdgcn_mfma_f32_32x32x16_bf16(kf[4],qr[2],C0,0,0,0),   P1[2],P1[3],P1[4],P1[5],     pw2[0]=PKW(P1,0), pw2[1]=PKW(P1,2), pw2); \
    VRD(6); SBAR(); GAPA(C1=__builtin_amdgcn_mfma_f32_32x32x16_bf16(kf[5],qr[2],C1,0,0,0),   P1[6],P1[7],P1[8],P1[9],     pw2[2]=PKW(P1,4), pw2[3]=PKW(P1,6), pw2); \
    VRD(3); SBAR(); GAPA(C0=__builtin_amdgcn_mfma_f32_32x32x16_bf16(kf[6],qr[3],C0,0,0,0),   P1[10],P1[11],P1[12],P1[13], pw3[0]=PKW(P1,8), pw3[1]=PKW(P1,10), pw3); \
    VRD(7); SBAR(); GAPA(C1=__builtin_amdgcn_mfma_f32_32x32x16_bf16(kf[7],qr[3],C1,0,0,0),   P1[14],P1[15],0.f,0.f,       pw3[2]=PKW(P1,12),pw3[3]=PKW(P1,14), pw3); \
    l_reg+=sacc; \
    if(GK){DMA_K((t)+3,sl_cur);} if(GV){DMA_V((t)+1,sl_next);} \
    CMASK(C0,C1,t); \
    { float a=MX3(C0[0],C0[1],C1[0]),b=MX3(C0[2],C0[3],C1[1]); a=MX3(a,C1[2],C1[3]); \
      _Pragma("unroll") for(int r=4;r<16;r+=4){a=MX3(a,C0[r],C0[r+1]);b=MX3(b,C0[r+2],C0[r+3]);a=MX3(a,C1[r],C1[r+1]);b=MX3(b,C1[r+2],C1[r+3]);} \
      float rm=__builtin_fmaxf(a,b); { auto rr=__builtin_amdgcn_permlane32_swap(__float_as_uint(rm),__float_as_uint(rm),false,false); rm=__builtin_fmaxf(__uint_as_float(rr[0]),__uint_as_float(rr[1])); } \
      resc=false; \
      if(__builtin_expect(__any(rm>(float)THRL),0)){ const float dl=__builtin_fmaxf(rm,0.f); mhat+=dl; \
        _Pragma("unroll") for(int r=0;r<16;++r){C0[r]-=dl;C1[r]-=dl;} \
        _Pragma("unroll") for(int r=0;r<16;++r)negm[r]=-mhat; asm volatile("":"+v"(negm)); \
        const float f=__builtin_amdgcn_exp2f(-dl); l_reg*=f; if(hi==0)wsf[r32]=f; resc=true; } } \
    SBAR(); \
    GAPB(o[0]=__builtin_amdgcn_mfma_f32_32x32x16_bf16(PAF(0),VFR(0),o[0],0,0,0), C0,0); \
    GAPB(o[1]=__builtin_amdgcn_mfma_f32_32x32x16_bf16(PAF(0),VFR(4),o[1],0,0,0), C0,4); \
    KRD(GL,0); GAPB(o[0]=__builtin_amdgcn_mfma_f32_32x32x16_bf16(PAF(1),VFR(1),o[0],0,0,0), C0,8); \
    KRD(GL,1); GAPB(o[1]=__builtin_amdgcn_mfma_f32_32x32x16_bf16(PAF(1),VFR(5),o[1],0,0,0), C0,12); \
    KRD(GL,2); GAPB(o[0]=__builtin_amdgcn_mfma_f32_32x32x16_bf16(PAF(2),VFR(2),o[0],0,0,0), C1,0); \
    KRD(GL,3); GAPB(o[1]=__builtin_amdgcn_mfma_f32_32x32x16_bf16(PAF(2),VFR(6),o[1],0,0,0), C1,4); \
    GAPB(o[0]=__builtin_amdgcn_mfma_f32_32x32x16_bf16(PAF(3),VFR(3),o[0],0,0,0), C1,8); \
    GAPB(o[1]=__builtin_amdgcn_mfma_f32_32x32x16_bf16(PAF(3),VFR(7),o[1],0,0,0), C1,12); \
    }while(0)
  int t=1;
  #undef CMASK
  #define CMASK(P0,P1,t) do{}while(0)
  for(;t+5<NT;t+=2){
    STEP(pB0,pB1,pA0,pA1,t,true,true,true);     WAIT_BAR(2); RESC(); ROT();
    STEP(pA0,pA1,pB0,pB1,t+1,true,true,true);   WAIT_BAR(2); RESC(); ROT();
  }
  #undef CMASK
  #define CMASK(P0,P1,t) do{}while(0)
  #define ENDW(tt) do{ if((tt)+3<NT){WAIT_BAR(2);} else if((tt)+2<NT){WAIT_BAR(1);} else {WAIT_BAR(0);} }while(0)
  for(;t+1<NT;t+=2){
    STEP(pB0,pB1,pA0,pA1,t,(t+3<NT),(t+1<NT),(t+1<NT));       ENDW(t);   RESC(); ROT();
    STEP(pA0,pA1,pB0,pB1,t+1,(t+4<NT),(t+2<NT),(t+2<NT));     ENDW(t+1); RESC(); ROT();
  }
  STEP(pB0,pB1,pA0,pA1,NT-1,false,false,false); RESC();
  { float sacc=pB0[0]+pB0[1]; _Pragma("unroll") for(int r=2;r<16;++r)sacc+=pB0[r]; _Pragma("unroll") for(int r=0;r<16;++r)sacc+=pB1[r]; l_reg+=sacc;
    pw0=(u32x4){PKW(pB0,0),PKW(pB0,2),PKW(pB0,4),PKW(pB0,6)};pw1=(u32x4){PKW(pB0,8),PKW(pB0,10),PKW(pB0,12),PKW(pB0,14)};pw2=(u32x4){PKW(pB1,0),PKW(pB1,2),PKW(pB1,4),PKW(pB1,6)};pw3=(u32x4){PKW(pB1,8),PKW(pB1,10),PKW(pB1,12),PKW(pB1,14)};
    SBAR(); pv(o,vb0+sl_cur,PAF(0),PAF(1),PAF(2),PAF(3)); }
  #undef PKW
  #undef PAF
  #undef VFR
  #undef PIN
  #undef MX3
  #undef GAPA
  #undef GAPB
  #undef EX
  #undef VRD
  #undef KRD
  #undef STEP
  #undef ENDW
  {auto rr=__builtin_amdgcn_permlane32_swap(__float_as_uint(l_reg),__float_as_uint(l_reg),false,false);l_reg=__uint_as_float(rr[0])+__uint_as_float(rr[1]);}
  if(hi==0)wsf[32+r32]=l_reg;asm volatile("s_waitcnt lgkmcnt(0)":::"memory");
  float rli[16];
  #pragma unroll
  for(int r=0;r<16;++r)rli[r]=__builtin_amdgcn_rcpf(wsf[32+crow(r,hi)]);
  bf16*Ow=O+(rowbase+q0+wid*QBLK)*QP+h*D; const bf16*Zw=Z+(rowbase+q0+wid*QBLK)*KP+h*D;
  { bf16*stg=(bf16*)(shm+LDS_OST)+wid*2048;
    #pragma unroll
    for(int r=0;r<16;++r){const int orow=crow(r,hi);
      #pragma unroll
      for(int d0=0;d0<2;++d0)stg[orow*64+d0*32+r32]=__float2bfloat16(o[d0][r]*rli[r]);}
    asm volatile("s_waitcnt lgkmcnt(0)":::"memory");
    #pragma unroll
    for(int i=0;i<4;++i){const int row=i*8+(lane>>3),ch=lane&7; const u32x4 v=*(const u32x4*)(stg+row*64+ch*8); const u32x4 zz=*(const u32x4*)(Zw+(long)row*KP+ch*8); u32x4 w;
      #pragma unroll
      for(int e=0;e<4;++e){const float a0=__uint_as_float(v[e]<<16)*__uint_as_float(zz[e]<<16),a1=__uint_as_float(v[e]&0xffff0000u)*__uint_as_float(zz[e]&0xffff0000u); w[e]=cvtpk_s(a0,a1);}
      if(wr_en)ATTN_STORE16(Ow+(long)row*QP+ch*8,w);} }
  asm volatile("s_waitcnt lgkmcnt(0)\n\ts_barrier":::"memory");
  #undef DMA_K
  #undef DMA_V
  #undef CMASK
  #undef START
  #undef RESC
  #undef ROT
}
constexpr int ATTN_LDS_BYTES=LDS_BYTES;
struct AttnTensors { const bf16* Q; const bf16* K; const bf16* V; const bf16* Z; bf16* O; };
template<int THRL=8> __device__ __forceinline__ void attn_phase(char*lds,const AttnTensors&T,int vcu,int G,bool wr_en){
  for(int U=vcu;U<BATCH*NHEAD*NQB;U+=G){ const int grp=U>>5,loc=U&31; const int b=grp&7,kvh=grp>>3,h=kvh*4+(loc>>3),qb=loc&7;
    attn_unit<THRL>(b,h,kvh,qb,T.Q,T.K,T.V,T.Z,T.O,lds,wr_en); }
}
#undef SBAR
#undef WAIT_BAR
}
constexpr int NWAVES = 8;
constexpr int BATCH = 8, SEQ = 2048, D = 1024, M = BATCH * SEQ, DEPTH = 2;
constexpr int INW = 7936, NMIX = 4864, NGATE = 3072, QUP = 1536, RESTP = 3328;
constexpr float LN_EPS = 1e-5f;
using pg8::LOG2E; using pg8::C2;
constexpr float ALPHA = 1.4142135623730951f;
constexpr size_t MiB = 1u << 20;
constexpr size_t WS_BIASV = 0;
constexpr size_t WS_WIN = 1 * MiB;
constexpr size_t WS_WBR = 32 * MiB;
constexpr size_t WS_WOUT = 38 * MiB;
constexpr size_t WS_SGW = 42 * MiB;
constexpr size_t WS_XN = 44 * MiB;
constexpr size_t WS_QU = 76 * MiB;
constexpr size_t WS_REST = 124 * MiB;
constexpr size_t WS_END = 229 * MiB;
constexpr int RING_OFF = 0;
constexpr int LDS_BYTES = 163840;
constexpr int MISC_OFF = LDS_BYTES - 64;
constexpr size_t WS_BAR = 228 * MiB;

#define GAS __attribute__((address_space(1)))
#define LAS __attribute__((address_space(3)))
typedef unsigned short bf16;
typedef unsigned v4u __attribute__((ext_vector_type(4)));
typedef unsigned v2u __attribute__((ext_vector_type(2)));
typedef float f32x4 __attribute__((ext_vector_type(4)));
typedef short bf16x8 __attribute__((ext_vector_type(8)));
#define LDS_WAIT() asm volatile("s_waitcnt lgkmcnt(0)" ::: "memory")
__device__ __forceinline__ unsigned f2bf(float f) { unsigned u = __builtin_bit_cast(unsigned, f); return (u + 0x7fffu + ((u >> 16) & 1u)) >> 16; }
__device__ __forceinline__ unsigned pk2(float lo, float hi) { return f2bf(lo) | (f2bf(hi) << 16); }
__device__ __forceinline__ float bflo(unsigned w) { return __uint_as_float(w << 16); }
__device__ __forceinline__ float bfhi(unsigned w) { return __uint_as_float(w & 0xffff0000u); }
__device__ __forceinline__ float wave_sum(float v) {
#pragma unroll
    for (int o = 1; o < 64; o <<= 1) v += __shfl_xor(v, o);
    return v;
}
__host__ __device__ __forceinline__ int v2l(int vc) {
    if (vc < 512) return vc;
    if (vc < 1024) return vc - 512 + 2048;
    if (vc < 1536) return vc - 1024 + 3328;
    if (vc < 2048) return vc - 1536 + 512;
    if (vc < 2560) return vc - 2048 + 1024;
    if (vc < 3072) return vc - 2560 + 1536;
    if (vc < 3200) return vc - 3072 + 2560;
    if (vc < 3328) return vc - 3200 + 2688;
    if (vc < 3840) return vc - 3328 + 2816;
    return vc;
}
__device__ __forceinline__ void transpose_item(const float* W, int N, int k0, int n0, bf16* WT, int ldt, int dst_row0, int kofs, LAS float* scr, int lane) {
#pragma unroll 8
    for (int i = 0; i < 32; ++i) { const int kk = 2 * i + (lane >> 5); scr[kk * 33 + (lane & 31)] = W[(size_t)(k0 + kk) * N + n0 + (lane & 31)]; }
    LDS_WAIT(); asm volatile("" ::: "memory");
    const int c = lane & 7;
#pragma unroll
    for (int j = 0; j < 4; ++j) { const int n = (lane >> 3) + 8 * j; const LAS float* s = scr + (8 * c) * 33 + n;
        v4u o; o.x = pk2(s[0 * 33], s[1 * 33]); o.y = pk2(s[2 * 33], s[3 * 33]); o.z = pk2(s[4 * 33], s[5 * 33]); o.w = pk2(s[6 * 33], s[7 * 33]);
        *(GAS v4u*)(WT + (size_t)(dst_row0 + n) * ldt + kofs + k0 + 8 * c) = o; }
    LDS_WAIT(); asm volatile("" ::: "memory");
}
__device__ __forceinline__ void ln_row(const float* xrow, const float* g, const float* bta, float* orow, bf16* brow, int lane, bool wr_en = true) {
    const GAS f32x4* xr = (const GAS f32x4*)xrow + lane;
    f32x4 v[4]; float s = 0.f;
#pragma unroll
    for (int j = 0; j < 4; ++j) { v[j] = xr[64 * j]; s += (v[j].x + v[j].y) + (v[j].z + v[j].w); }
    const float mean = wave_sum(s) * (1.f / D); float s2 = 0.f;
#pragma unroll
    for (int j = 0; j < 4; ++j) { v[j] = v[j] - mean; s2 += (v[j].x * v[j].x + v[j].y * v[j].y) + (v[j].z * v[j].z + v[j].w * v[j].w); }
    const float rstd = 1.f / sqrtf(wave_sum(s2) * (1.f / D) + LN_EPS);
    GAS f32x4* o4 = (GAS f32x4*)orow + lane; GAS v2u* o8 = (GAS v2u*)brow + lane;
#pragma unroll
    for (int j = 0; j < 4; ++j) { const f32x4 gg = ((const GAS f32x4*)g)[lane + 64 * j], bb = ((const GAS f32x4*)bta)[lane + 64 * j]; const f32x4 y = v[j] * rstd * gg + bb;
        if (wr_en) { o4[64 * j] = y; v2u w; w.x = pk2(y.x, y.y); w.y = pk2(y.z, y.w); o8[64 * j] = w; } }
}

#define RLX_AGENT __ATOMIC_RELAXED, __HIP_MEMORY_SCOPE_AGENT
#define XB_TMO      128
#define XB_XCNT(j)  (256  + 64 * (j))
#define XB_XSUB(j)  (1280 + 64 * (j))
#define XB_XGEN(j)  (2304 + 64 * (j))
#define XB_TOP      3328
#define XB_TOPGEN   3392
#define XCD_BAR_WORDS 3456
#define XB_SPIN_CAP (1u << 18)

__device__ __forceinline__ unsigned xb_ld(unsigned* p)              { return __hip_atomic_load(p, __ATOMIC_RELAXED, __HIP_MEMORY_SCOPE_AGENT); }
__device__ __forceinline__ unsigned xb_add(unsigned* p, unsigned v) { return __hip_atomic_fetch_add(p, v, __ATOMIC_RELAXED, __HIP_MEMORY_SCOPE_AGENT); }
__device__ __forceinline__ unsigned xb_xcc_id() { return (unsigned)__builtin_amdgcn_s_getreg((3 << 11) | 20) & 0xFu; }
#define XB_SPIN(cond, bar) do { unsigned _sp = 0; while (cond) { __builtin_amdgcn_s_sleep(1); \
    if ((++_sp & 255u) == 0u) { if (xb_ld(&(bar)[XB_TMO])) break; if (_sp > XB_SPIN_CAP) { atomicAdd(&(bar)[XB_TMO], 1u); break; } } } } while (0)

struct XcdBarrier {
    unsigned* bar; unsigned x;
    volatile LAS unsigned* st;
};

__device__ __forceinline__ XcdBarrier xcd_barrier_post(unsigned* bar, volatile LAS unsigned* st) {
    XcdBarrier b; b.bar = bar; b.x = xb_xcc_id(); b.st = st;
    if (threadIdx.x == 0) (void)xb_add(&bar[XB_XCNT(b.x)], 1u);
    return b;
}
__device__ __forceinline__ void xcd_barrier_complete(unsigned* bar, unsigned x, unsigned& nloc, unsigned& nx) {
    const unsigned G = gridDim.x * gridDim.y * gridDim.z;
    unsigned sum, cnt, mine, sp = 0u;
    for (;;) {
        sum = 0u; cnt = 0u; mine = 0u;
#pragma unroll
        for (unsigned j = 0; j < 16; ++j) { const unsigned c = xb_ld(&bar[XB_XCNT(j)]); sum += c; cnt += (c > 0u) ? 1u : 0u; mine = (j == x) ? c : mine; }
        if (sum == G) break;
        __builtin_amdgcn_s_sleep(1);
        if ((++sp & 255u) == 0u) { if (xb_ld(&bar[XB_TMO])) break; if (sp > XB_SPIN_CAP) { atomicAdd(&bar[XB_TMO], 1u); break; } }
    }
    nloc = mine > 0u ? mine : 1u; nx = cnt > 0u ? cnt : 1u;
}

__device__ __forceinline__ void xcd_barrier(const XcdBarrier& b) {
    asm volatile("s_waitcnt vmcnt(0)" ::: "memory");
    __syncthreads();
    if (threadIdx.x == 0) {
        unsigned* bar = b.bar;
        __builtin_amdgcn_s_waitcnt(0);
        unsigned nloc = b.st[0], nx = b.st[1];
        if (nloc == 0u) { xcd_barrier_complete(bar, b.x, nloc, nx); b.st[0] = nloc; b.st[1] = nx; }
        const unsigned old = xb_add(&bar[XB_XSUB(b.x)], 1u);
        const unsigned gen = old / nloc;
        if (old + 1u == (gen + 1u) * nloc) {
            __builtin_amdgcn_fence(__ATOMIC_RELEASE, "agent");
            asm volatile("s_waitcnt vmcnt(0)" ::: "memory");
            const unsigned og = xb_add(&bar[XB_TOP], 1u);
            const unsigned tg = og / nx;
            if (og + 1u == (tg + 1u) * nx) xb_add(&bar[XB_TOPGEN], 1u);
            else XB_SPIN(xb_ld(&bar[XB_TOPGEN]) == tg, bar);
            __builtin_amdgcn_fence(__ATOMIC_ACQUIRE, "agent");
            xb_add(&bar[XB_XGEN(b.x)], 1u);
            asm volatile("s_waitcnt vmcnt(0)" ::: "memory");
        } else {
            XB_SPIN(xb_ld(&bar[XB_XGEN(b.x)]) == gen, bar);
            __builtin_amdgcn_fence(__ATOMIC_ACQUIRE, "agent");
            asm volatile("s_waitcnt vmcnt(0)" ::: "memory");
        }
    }
    __syncthreads();
}

constexpr int NA_K = 0, NA_V = 65536, NA_MS = 131072, NA_ML = NA_MS + 4 * 16 * 68 * 4, NA_RP = NA_ML + 8 * 32 * 4, NA_END = NA_RP + 480 * 4;
static_assert(NA_END <= LDS_BYTES, "NA LDS map");
__device__ __forceinline__ void na_stage_write(LAS unsigned char* lds, int slot, int key, int dc, v4u kv, v4u vv) {
    *(LAS v4u*)(lds + NA_K + slot * 8192 + key * 128 + ((dc ^ (key & 7)) << 4)) = kv;
    LAS unsigned char* vb = lds + NA_V + slot * 8192 + (dc * 8) * 128 + (key & 7) * 2; const int kc = key >> 3;
#pragma unroll
    for (int e = 0; e < 4; ++e) {
        *(LAS unsigned short*)(vb + (2 * e) * 128 + ((kc ^ (2 * e)) << 4)) = (unsigned short)(vv[e] & 0xffffu);
        *(LAS unsigned short*)(vb + (2 * e + 1) * 128 + ((kc ^ (2 * e + 1)) << 4)) = (unsigned short)(vv[e] >> 16); }
}
__device__ __forceinline__ void na_unit(LAS unsigned char* lds, int b, int h, int oct, bf16* QU, const bf16* REST, const float* rpb, bool wr_en) {
    int tid_ = threadIdx.x; asm volatile("" : "+v"(tid_)); const int tid = tid_, lane = tid & 63, wid = __builtin_amdgcn_readfirstlane(tid >> 6), fr = lane & 15, fq = lane >> 4;
    const int qb = wid & 3, kh = wid >> 2, c0 = 16 * qb, w0 = min(max(16 * qb - 8, 0), 32);
    bf16* Qb = QU + (size_t)b * SEQ * QUP + h * 64;
    const bf16* Kb = REST + (size_t)b * SEQ * RESTP + h * 64; const bf16* Vb = Kb + 512; const bf16* Zb = Kb + 1024;
    LAS float* RP = (LAS float*)(lds + NA_RP); LAS float* ML = (LAS float*)(lds + NA_ML); LAS float* MS = (LAS float*)(lds + NA_MS);
    if (tid < 465) RP[tid] = rpb[h * 465 + tid] * LOG2E;
    const int skey = tid >> 3, sdc = tid & 7;
    int rs = min(max(8 * oct - 4, 0), 24);
#pragma unroll
    for (int half = 0; half < 2; ++half) { v4u kv[4], vv[4];
#pragma unroll
        for (int j = 0; j < 4; ++j) { const int kr = rs + half * 4 + j; const size_t off = (size_t)(kr * 64 + skey) * RESTP + sdc * 8; kv[j] = *(const v4u*)(Kb + off); vv[j] = *(const v4u*)(Vb + off); }
#pragma unroll
        for (int j = 0; j < 4; ++j) { const int kr = rs + half * 4 + j; na_stage_write(lds, kr & 7, skey, sdc, kv[j], vv[j]); } }
    __syncthreads();
    for (int i = 0; i < 8; ++i) {
        const int r = 8 * oct + i;
        const int rs_next = (i < 7) ? min(max(r + 1 - 4, 0), 24) : rs; const bool adv = rs_next > rs;
        v4u pk = (v4u){0u, 0u, 0u, 0u}, pv = pk;
        if (adv) { const size_t off = (size_t)((rs_next + 7) * 64 + skey) * RESTP + sdc * 8; pk = *(const v4u*)(Kb + off); pv = *(const v4u*)(Vb + off); }
        const bf16* qp = Qb + (size_t)(r * 64 + c0 + fr) * QUP + fq * 8;
        const bf16x8 q0 = *(const bf16x8*)qp, q1 = *(const bf16x8*)(qp + 32);
        const int c = c0 + fr, cs = min(max(c - 8, 0), 48);
        float sc[4][8]; float mx = -1e30f;
        const int keya = w0 + 8 * (fr >> 2) + (fr & 3);
#pragma unroll
        for (int jr = 0; jr < 4; ++jr) { const int kr = rs + kh * 4 + jr, slot = kr & 7;
            const LAS unsigned char* kb = lds + NA_K + slot * 8192;
            const int ka = keya, kbk = keya + 4;
            const bf16x8 a0 = *(const LAS bf16x8*)(kb + ka * 128 + ((fq ^ (ka & 7)) << 4)), a1 = *(const LAS bf16x8*)(kb + ka * 128 + (((4 + fq) ^ (ka & 7)) << 4));
            const bf16x8 b0 = *(const LAS bf16x8*)(kb + kbk * 128 + ((fq ^ (kbk & 7)) << 4)), b1 = *(const LAS bf16x8*)(kb + kbk * 128 + (((4 + fq) ^ (kbk & 7)) << 4));
            f32x4 sa = (f32x4){0.f, 0.f, 0.f, 0.f}, sb = sa;
            sa = __builtin_amdgcn_mfma_f32_16x16x32_bf16(a0, q0, sa, 0, 0, 0); sa = __builtin_amdgcn_mfma_f32_16x16x32_bf16(a1, q1, sa, 0, 0, 0);
            sb = __builtin_amdgcn_mfma_f32_16x16x32_bf16(b0, q0, sb, 0, 0, 0); sb = __builtin_amdgcn_mfma_f32_16x16x32_bf16(b1, q1, sb, 0, 0, 0);
            const LAS float* rprow = RP + (kr - r + 7) * 31 + 15 - c;
#pragma unroll
            for (int jj = 0; jj < 8; ++jj) { const int k = w0 + 8 * fq + jj; const bool ok = (k >= cs) && (k < cs + 16);
                const float s = (jj < 4 ? sa[jj] : sb[jj - 4]) + (ok ? rprow[k] : 0.f);
                sc[jr][jj] = ok ? s : -1e30f; mx = fmaxf(mx, sc[jr][jj]); } }
        mx = fmaxf(mx, __shfl_xor(mx, 16)); mx = fmaxf(mx, __shfl_xor(mx, 32));
        float ls = 0.f; bf16x8 pa[4];
#pragma unroll
        for (int jr = 0; jr < 4; ++jr) { float p[8];
#pragma unroll
            for (int jj = 0; jj < 8; ++jj) { p[jj] = __builtin_amdgcn_exp2f(sc[jr][jj] - mx); ls += p[jj]; }
            v4u w; w.x = pk2(p[0], p[1]); w.y = pk2(p[2], p[3]); w.z = pk2(p[4], p[5]); w.w = pk2(p[6], p[7]); pa[jr] = __builtin_bit_cast(bf16x8, w); }
        ls += __shfl_xor(ls, 16); ls += __shfl_xor(ls, 32);
        f32x4 o[4];
#pragma unroll
        for (int db = 0; db < 4; ++db) { o[db] = (f32x4){0.f, 0.f, 0.f, 0.f}; const int d = 16 * db + fr;
#pragma unroll
            for (int jr = 0; jr < 4; ++jr) { const int slot = (rs + kh * 4 + jr) & 7;
                const bf16x8 vb = *(const LAS bf16x8*)(lds + NA_V + slot * 8192 + d * 128 + ((((w0 >> 3) + fq) ^ (d & 7)) << 4));
                o[db] = __builtin_amdgcn_mfma_f32_16x16x32_bf16(pa[jr], vb, o[db], 0, 0, 0); } }
        if (fq == 0) { ML[wid * 32 + fr] = mx; ML[wid * 32 + 16 + fr] = ls; }
        if (kh == 1) {
#pragma unroll
            for (int db = 0; db < 4; ++db)
#pragma unroll
                for (int j = 0; j < 4; ++j) MS[(qb * 16 + 4 * fq + j) * 68 + 16 * db + fr] = o[db][j]; }
        __syncthreads();
        if (adv) na_stage_write(lds, (rs_next + 7) & 7, skey, sdc, pk, pv);
        if (kh == 0) {
#pragma unroll
            for (int j = 0; j < 4; ++j) { const int q = 4 * fq + j;
                const float m0 = ML[wid * 32 + q], l0 = ML[wid * 32 + 16 + q], m1 = ML[(wid + 4) * 32 + q], l1 = ML[(wid + 4) * 32 + 16 + q];
                const float mt = fmaxf(m0, m1), a0 = __builtin_amdgcn_exp2f(m0 - mt), a1 = __builtin_amdgcn_exp2f(m1 - mt), inv = 1.0f / (l0 * a0 + l1 * a1);
                const size_t tok = (size_t)(r * 64 + c0 + q);
#pragma unroll
                for (int db = 0; db < 4; ++db) { const int d = 16 * db + fr;
                    const float ov = (o[db][j] * a0 + MS[(qb * 16 + q) * 68 + d] * a1) * inv;
                    const float z = __uint_as_float((unsigned)Zb[tok * RESTP + d] << 16);
                    if (wr_en) Qb[tok * QUP + d] = (bf16)f2bf(ov * z); } } }
        __syncthreads();
        rs = rs_next;
    }
}

__device__ __forceinline__ void sg_unit(LAS unsigned char* lds, int b, int chunk, int gh, bf16* QU, const bf16* REST, const float* lng, const float* lnb, const bf16* sgw, const float* sgb, bool wr_en) {
    int tid_ = threadIdx.x; asm volatile("" : "+v"(tid_)); const int tid = tid_, lane = tid & 63, wid = __builtin_amdgcn_readfirstlane(tid >> 6), fr = lane & 15, fq = lane >> 4;
    const size_t tok0 = (size_t)b * SEQ + chunk * 128;
    const bf16* Vp = REST + tok0 * RESTP + 2304; const bf16* Zp = REST + tok0 * RESTP + 2816; bf16* Up = QU + tok0 * QUP + 1024;
    {
        f32x4 g0 = *(const f32x4*)(lng + lane * 8), g1 = *(const f32x4*)(lng + lane * 8 + 4), b0 = *(const f32x4*)(lnb + lane * 8), b1 = *(const f32x4*)(lnb + lane * 8 + 4);
        const bool mine = (lane >> 5) == gh; const int cl0 = (lane & 31) * 8;
        for (int i = 0; i < 16; ++i) { const int n = wid * 16 + i;
            const v4u raw = *(const v4u*)(Vp + (size_t)n * RESTP + lane * 8);
            float x[8];
#pragma unroll
            for (int e = 0; e < 4; ++e) { x[2 * e] = bflo(raw[e]); x[2 * e + 1] = bfhi(raw[e]); }
            float s = 0.f;
#pragma unroll
            for (int e = 0; e < 8; ++e) s += x[e];
            const float mean = wave_sum(s) * (1.0f / 512.0f); float s2 = 0.f;
#pragma unroll
            for (int e = 0; e < 8; ++e) { x[e] -= mean; s2 += x[e] * x[e]; }
            const float rstd = 1.f / sqrtf(wave_sum(s2) * (1.0f / 512.0f) + LN_EPS);
            if (mine) {
#pragma unroll
                for (int e = 0; e < 8; ++e) { const float y = x[e] * rstd * (e < 4 ? g0[e] : g1[e - 4]) + (e < 4 ? b0[e] : b1[e - 4]); const int cl = cl0 + e;
                    *(LAS unsigned short*)(lds + cl * 256 + (((n >> 3) ^ (cl & 15)) << 4) + (n & 7) * 2) = (unsigned short)f2bf(y); } }
        }
    }
    __syncthreads();
    {
        const int gl = wid & 3, g = 4 * gh + gl, mh = wid >> 2;
        const bf16* Wg = sgw + (size_t)g * 128 * 128;
        f32x4 acc[4][4];
#pragma unroll
        for (int db = 0; db < 4; ++db)
#pragma unroll
            for (int mb = 0; mb < 4; ++mb) acc[db][mb] = (f32x4){0.f, 0.f, 0.f, 0.f};
#pragma unroll
        for (int ks = 0; ks < 4; ++ks) { bf16x8 af[4], bfr[4];
#pragma unroll
            for (int db = 0; db < 4; ++db) { const int cl = gl * 64 + 16 * db + fr; af[db] = *(const LAS bf16x8*)(lds + cl * 256 + (((ks * 4 + fq) ^ (cl & 15)) << 4)); }
#pragma unroll
            for (int mb = 0; mb < 4; ++mb) bfr[mb] = *(const bf16x8*)(Wg + (size_t)(64 * mh + 16 * mb + fr) * 128 + ks * 32 + fq * 8);
#pragma unroll
            for (int db = 0; db < 4; ++db)
#pragma unroll
                for (int mb = 0; mb < 4; ++mb) acc[db][mb] = __builtin_amdgcn_mfma_f32_16x16x32_bf16(af[db], bfr[mb], acc[db][mb], 0, 0, 0); }
#pragma unroll
        for (int mb = 0; mb < 4; ++mb) { const int m = 64 * mh + 16 * mb + fr; const float bs = sgb[g * 128 + m];
#pragma unroll
            for (int db = 0; db < 4; ++db) { const int c = 64 * g + 16 * db + 4 * fq;
                const v2u uu = *(const v2u*)(Up + (size_t)m * QUP + c), zz = *(const v2u*)(Zp + (size_t)m * RESTP + c); const f32x4 a = acc[db][mb];
                v2u w; w.x = pk2(bflo(uu.x) * (a[0] + bs) * bflo(zz.x), bfhi(uu.x) * (a[1] + bs) * bfhi(zz.x)); w.y = pk2(bflo(uu.y) * (a[2] + bs) * bflo(zz.y), bfhi(uu.y) * (a[3] + bs) * bfhi(zz.y));
                if (wr_en) *(v2u*)(Up + (size_t)m * QUP + c) = w; } }
    }
    __syncthreads();
}
struct Args {
    const float *x, *ln_in_g, *ln_in_b, *w_in, *b_in, *na_rpb, *q_norm_g, *k_norm_g, *sg_ln_g, *sg_ln_b, *sg_w, *sg_b, *w_br_a, *w_br_b, *w_br_c, *w_out, *b_out, *ln_post_g, *ln_post_b;
    float* out; unsigned char* ws; int force; int pad;
};
#ifndef PROBE
#define PROBE 0
#endif
typedef const __attribute__((address_space(4))) Args* KArgs;
__device__ __forceinline__ KArgs kargs() { KArgs p = (KArgs)__builtin_amdgcn_kernarg_segment_ptr(); asm volatile("" : "+s"(p)); return p; }
#define WSP(off) ((unsigned char*)kargs()->ws + (off))
__global__ void __launch_bounds__(NWAVES * 64, 2) mega_fwd(Args a_unused) {
    extern __shared__ __attribute__((aligned(16))) unsigned char lds_raw[];
    cg::grid_group grid = cg::this_grid();
    LAS unsigned char* lds = (LAS unsigned char*)lds_raw;
    const int tid = threadIdx.x, lane = tid & 63, wave = __builtin_amdgcn_readfirstlane(tid >> 6);
    const int G = gridDim.x, bx = blockIdx.x; const int vcu = (G % 8 == 0) ? (bx % 8) * (G / 8) + bx / 8 : bx;
    if (tid < 16) ((LAS unsigned*)(lds + MISC_OFF))[tid] = 0u;
    if (bx == 0) { unsigned* barw = (unsigned*)WSP(WS_BAR); for (int i = tid; i < XCD_BAR_WORDS; i += NWAVES * 64) barw[i] = 0u; }
    __syncthreads();
    const int gw = vcu * NWAVES + wave, NGW = G * NWAVES;
#define BIASV ((float*)WSP(WS_BIASV))
#define WIN ((bf16*)WSP(WS_WIN))
#define WBR ((bf16*)WSP(WS_WBR))
#define WOUT ((bf16*)WSP(WS_WOUT))
#define SGW ((bf16*)WSP(WS_SGW))
#define XN ((bf16*)WSP(WS_XN))
#define QU ((bf16*)WSP(WS_QU))
#define REST ((bf16*)WSP(WS_REST))
#define GT REST
#define H (kargs()->out)

    for (int rep = 0; rep < ((PROBE & 64) ? 2 : 1); ++rep) {
        LAS float* scr = (LAS float*)(lds + wave * 16384);
        constexpr int I_IN = 16 * (INW / 32), I_BR = 8 * 32, I_OUT = 16 * 32;
        constexpr int PER_L = I_IN + 3 * I_BR + I_OUT, NITEMS = DEPTH * PER_L;
        for (int it = gw; it < NITEMS; it += NGW) {
            const int l = it / PER_L; int r = it % PER_L;
            if (r < I_IN) { const int kb = r / (INW / 32), pb = r % (INW / 32);
                const int tile = pb >> 3, wblk = pb & 7, bj = wblk >> 2, wc = wblk & 3; const int vc0 = tile * 256 + wc * 64 + bj * 32;
                transpose_item(kargs()->w_in + (size_t)l * D * INW, INW, 64 * kb, v2l(vc0), WIN + (size_t)l * INW * D, D, 32 * pb, 0, scr, lane); continue; }
            r -= I_IN;
            if (r < 3 * I_BR) { const int br = r / I_BR, q = r % I_BR, kb = q / 32, nb = q % 32; const float* W = (br == 0 ? kargs()->w_br_a : br == 1 ? kargs()->w_br_b : kargs()->w_br_c) + (size_t)l * 512 * D;
                transpose_item(W, D, 64 * kb, 32 * nb, WBR + (size_t)l * D * 1536, 1536, 32 * nb, 512 * br, scr, lane); continue; }
            r -= 3 * I_BR;
            { const int kb = r / 32, nb = r % 32; transpose_item(kargs()->w_out + (size_t)l * D * D, D, 64 * kb, 32 * nb, WOUT + (size_t)l * D * D, D, 32 * nb, 0, scr, lane); }
        }
        const int gt = (vcu * NWAVES + wave) * 64 + lane, NGT = NGW * 64;
        for (int i = gt; i < DEPTH * 8 * 128 * 128 / 2; i += NGT) { const float2 v = ((const float2*)kargs()->sg_w)[i]; ((unsigned*)SGW)[i] = pk2(v.x, v.y); }
        for (int i = gt; i < DEPTH * INW; i += NGT) { const int l = i / INW, p = i % INW; BIASV[i] = kargs()->b_in[l * INW + v2l(p)]; }
        for (int m = gw; m < M; m += NGW) ln_row(kargs()->x + (size_t)m * D, kargs()->ln_in_g, kargs()->ln_in_b, H + (size_t)m * D, XN + (size_t)m * D, lane);
    }
    grid.sync();
    (void)xcd_barrier_post((unsigned*)WSP(WS_BAR), (volatile LAS unsigned*)(lds + MISC_OFF));
#define GRID_BAR() do { XcdBarrier b_; b_.bar = (unsigned*)WSP(WS_BAR); b_.x = xb_xcc_id(); b_.st = (volatile LAS unsigned*)(lds + MISC_OFF); xcd_barrier(b_); } while (0)

    for (int l = 0; l < DEPTH; ++l) {
#ifndef NO_P1
        for (int rep = 0; rep < ((PROBE & 16) ? 2 : 1); ++rep) {
            pg8::Gemm g{XN, WIN + (size_t)l * INW * D, M, NMIX, D, D, D}; pg8::StaticOrder S; S.init(M, NMIX, G, bx);
            pg8::EpiIn E{QU, REST, GT, BIASV + l * INW, kargs()->q_norm_g + l * 64, kargs()->k_norm_g + l * 64, 0};
            pg8::gemm_phase<pg8::EpiIn, pg8::StaticOrder, true, true>(lds + RING_OFF, g, S, E);
        }
#endif
        GRID_BAR();
        {
            const attn_body::AttnTensors AT{(const attn_body::bf16*)(QU + 512), (const attn_body::bf16*)(REST + 1536), (const attn_body::bf16*)(REST + 1664), (const attn_body::bf16*)(REST + 1792), (attn_body::bf16*)(QU + 512)};
#ifndef NO_ATT
            for (int rep = 0; rep < ((PROBE & 8) ? 2 : 1); ++rep) { attn_body::attn_phase<8>((char*)lds_raw + RING_OFF, AT, vcu, G, (rep == ((PROBE & 8) ? 1 : 0)) || (kargs()->force != 0)); __syncthreads(); }
#endif
            __syncthreads();
#ifndef NO_NA
            for (int rep = 0; rep < ((PROBE & 2) ? 2 : 1); ++rep)
            for (int U = vcu; U < BATCH * 8 * 4; U += G) na_unit(lds, U >> 5, (U >> 2) & 7, U & 3, QU, REST, kargs()->na_rpb + (size_t)l * 8 * 465, (rep == ((PROBE & 2) ? 1 : 0)) || (kargs()->force != 0));
#endif
            __syncthreads();
#ifndef NO_SG
            for (int rep = 0; rep < ((PROBE & 4) ? 2 : 1); ++rep)
            for (int U = vcu; U < BATCH * 16 * 2; U += G) sg_unit(lds, U >> 5, (U >> 1) & 15, U & 1, QU, REST, kargs()->sg_ln_g + l * 512, kargs()->sg_ln_b + l * 512, SGW + (size_t)l * 8 * 128 * 128, kargs()->sg_b + l * 8 * 128, (rep == ((PROBE & 4) ? 1 : 0)) || (kargs()->force != 0));
#endif
        }
        GRID_BAR();
#ifndef NO_P1B
        for (int rep = 0; rep < ((PROBE & 32) ? 2 : 1); ++rep) {
            pg8::Gemm g{XN, WIN + (size_t)l * INW * D + (size_t)NMIX * D, M, NGATE, D, D, D}; pg8::StaticOrder S; S.init(M, NGATE, G, bx);
            pg8::EpiIn E{QU, REST, GT, BIASV + l * INW, kargs()->q_norm_g + l * 64, kargs()->k_norm_g + l * 64, 19};
            pg8::gemm_phase<pg8::EpiIn, pg8::StaticOrder, true, true>(lds + RING_OFF, g, S, E);
        }
#endif
        GRID_BAR();
#ifndef NO_P3
        for (int rep = 0; rep < ((PROBE & 32) ? 2 : 1); ++rep) {
            pg8::Gemm g{QU, WBR + (size_t)l * D * 1536, M, D, 1536, 1536, 1536}; pg8::StaticOrder S; S.init(M, D, G, bx);
            pg8::EpiMerge E{GT, XN};
            pg8::gemm_phase<pg8::EpiMerge, pg8::StaticOrder, true, true>(lds + RING_OFF, g, S, E);
        }
#endif
        GRID_BAR();
#ifndef NO_P4
        for (int rep = 0; rep < ((PROBE & 128) ? 2 : 1); ++rep) {
            pg8::Gemm g{XN, WOUT + (size_t)l * D * D, M, D, D, D, D}; pg8::StaticOrder S; S.init(M, D, G, bx);
            pg8::EpiOut E{H, kargs()->b_out + l * D, ALPHA, (rep == ((PROBE & 128) ? 1 : 0)) || (kargs()->force != 0)};
            pg8::gemm_phase<pg8::EpiOut, pg8::StaticOrder, true, true>(lds + RING_OFF, g, S, E);
        }
#endif
        GRID_BAR();
        for (int rep = 0; rep < ((PROBE & 256) ? 2 : 1); ++rep)
        for (int m = gw; m < M; m += NGW) ln_row(H + (size_t)m * D, kargs()->ln_post_g + l * D, kargs()->ln_post_b + l * D, H + (size_t)m * D, XN + (size_t)m * D, lane, (rep == ((PROBE & 256) ? 1 : 0)) || (kargs()->force != 0));
        if (l + 1 < DEPTH) GRID_BAR();
        if (PROBE & 1) { for (int i = 0; i < 6; ++i) GRID_BAR(); }
    }
}

extern "C" void kernel_launch(void* const* d_in, const int* in_sizes, int n_in, void* d_out, int out_size, void* d_ws, size_t ws_size, hipStream_t stream) {
    static int grid = 0;
    if (grid == 0) {
        if (n_in != 19 || in_sizes[0] != M * D || out_size != M * D || ws_size < WS_END) { fprintf(stderr, "kernel_launch: unexpected shapes (n_in %d, in0 %d, out %d, ws %zu); nothing launched\n", n_in, n_in > 0 ? in_sizes[0] : -1, out_size, ws_size); grid = -1; return; }
        int dev = 0, cus = 0, per_cu = 0;
        if (hipGetDevice(&dev) != hipSuccess || hipDeviceGetAttribute(&cus, hipDeviceAttributeMultiprocessorCount, dev) != hipSuccess) { grid = -1; return; }
        if (hipFuncSetAttribute((const void*)mega_fwd, hipFuncAttributeMaxDynamicSharedMemorySize, LDS_BYTES) != hipSuccess) { fprintf(stderr, "kernel_launch: hipFuncSetAttribute failed\n"); grid = -1; return; }
        if (hipOccupancyMaxActiveBlocksPerMultiprocessor(&per_cu, (const void*)mega_fwd, NWAVES * 64, LDS_BYTES) != hipSuccess || per_cu < 1) { fprintf(stderr, "kernel_launch: occupancy query reports %d\n", per_cu); per_cu = 1; }
        (void)hipGetLastError();
        grid = cus * per_cu;
    }
    if (grid < 0) return;
    Args a{};
    const float** f = (const float**)&a;
    for (int i = 0; i < 19; ++i) f[i] = (const float*)d_in[i];
    a.out = (float*)d_out; a.ws = (unsigned char*)d_ws;
    void* args[] = {&a};
    const hipError_t e = hipLaunchCooperativeKernel((const void*)mega_fwd, dim3(grid), dim3(NWAVES * 64), args, LDS_BYTES, stream);
    if (e != hipSuccess) fprintf(stderr, "kernel_launch: cooperative launch failed: %s (grid %d)\n", hipGetErrorString(e), grid);
}
```

```cpp
#include <hip/hip_runtime.h>
#include <hip/hip_cooperative_groups.h>
#include <cstdio>
#include <cstdint>
namespace cg = cooperative_groups;
namespace pg8 {
#define PG8_LAS __attribute__((address_space(3)))
typedef unsigned short bf16_t;
typedef short bf16x8 __attribute__((ext_vector_type(8)));
typedef float f32x4 __attribute__((ext_vector_type(4)));
typedef unsigned u32x4 __attribute__((ext_vector_type(4)));
constexpr int BM = 256, BK = 64, HALF = 128, HTB = HALF * BK * 2  , STAGE_BYTES = 8 * HTB, NXCD = 8, WGM = 8;

__host__ __device__ __forceinline__ int lds_byte(int r, int c) { const int st = (r >> 4) * 2 + (c >> 5), rr = r & 15, cc = c & 31, ob = rr * 64 + cc * 2; return st * 1024 + (ob ^ (((ob >> 9) & 1) << 5)); }
__host__ __device__ __forceinline__ void stage_rc(int b, int& R, int& C) { const int st = b / 1024, sb = b % 1024, swz = sb ^ (((sb >> 9) & 1) << 5); R = (st >> 1) * 16 + swz / 64; C = (st & 1) * 32 + (swz % 64) / 2; }
__host__ __device__ __forceinline__ int perm32(int rho) { const int n = rho >> 4, i = rho & 15; return 8 * (i >> 2) + 4 * n + (i & 3); }

struct Unit { int pm, pn; };
struct Gemm { const bf16_t* A; const bf16_t* Bt; int M, N, K, lda, ldb; };

struct StaticOrder {
    int nM, nN, nwg, G, c;
    __host__ __device__ void init(int M, int N, int G_, int c_) { nM = M / BM; nN = N / BM; nwg = nM * nN; G = G_; c = c_; }
    __host__ __device__ bool next(int i, Unit& u) const {
        const long L = (long)i * G + c; if (L >= nwg) return false;
        int wgid = (int)L; { const int q = nwg / NXCD, r = nwg % NXCD, xcd = wgid % NXCD, off = wgid / NXCD; wgid = (xcd < r ? xcd * (q + 1) : r * (q + 1) + (xcd - r) * q) + off; }
        const int nig = WGM * nN, gid = wgid / nig, fm = gid * WGM, gsz = (nM - fm) < WGM ? (nM - fm) : WGM;
        u.pm = fm + ((wgid % nig) % gsz); u.pn = (wgid % nig) / gsz; return true;
    }
    __device__ __forceinline__ void a_ready(const Unit&) const {}
    __device__ __forceinline__ void done(const Unit&) const {}
};

__device__ __forceinline__ unsigned cvt_pk_bf16(float lo, float hi) { unsigned r; asm volatile("v_cvt_pk_bf16_f32 %0, %1, %2" : "=v"(r) : "v"(lo), "v"(hi)); return r; }
__device__ __forceinline__ float bf_lo(unsigned w) { return __uint_as_float(w << 16); }
__device__ __forceinline__ float bf_hi(unsigned w) { return __uint_as_float(w & 0xffff0000u); }
constexpr float LOG2E = 1.4426950408889634f;
constexpr float C2 = 0.125f * LOG2E;
__device__ __forceinline__ float sigmoid_f(float x) { return __builtin_amdgcn_rcpf(1.0f + __builtin_amdgcn_exp2f(-x * LOG2E)); }

struct EpiIn {
    static constexpr bool PERM = true, AFTER_DRAIN = false, MIDHOOK = false;
    bf16_t* QU; bf16_t* REST; const float* biasv; const float* qg; const float* kg;
    __device__ __forceinline__ void operator()(const f32x4 (&acc)[2][2][4][2], const Unit& u, int wr, int wc, int fr, int fq) const {
        const int vt = u.pn;
        const int vc0 = vt * 256 + wc * 64 + fq * 8;
        bf16_t* dst; int pitch, dcol;
        if (vt < 6) { dst = QU; pitch = 1536; dcol = vc0; } else { dst = REST; pitch = 3328; dcol = vc0 - 1536; }
        int type = 0; float sc = 1.f; const float* ng = qg;
        if (vt < 2) sc = C2;
        else if (vt < 4) { type = 3; sc = C2; }
        else if (vt == 10 || vt == 11 || vt == 13 || vt == 14 || vt == 17 || vt == 18) type = 1;
        else if (vt == 12) { if (wc < 2) { type = 3; ng = kg; } }
        f32x4 bv[2][2];
#pragma unroll
        for (int bj = 0; bj < 2; ++bj)
#pragma unroll
            for (int n = 0; n < 2; ++n) bv[bj][n] = *(const f32x4*)(biasv + vc0 + bj * 32 + 4 * n);
        const int row0 = u.pm * BM + wr * 64 + fr;
        if (type == 3) {
#pragma unroll
            for (int ai = 0; ai < 2; ++ai)
#pragma unroll
                for (int m = 0; m < 4; ++m) {
                    asm volatile("" ::: "memory");
                    int fqo = fq; asm volatile("" : "+v"(fqo));
                    const float* bp = biasv + vt * 256 + wc * 64 + fqo * 8; const float* gp = ng + fqo * 8;
                    const int row = row0 + ai * HALF + m * 16; const int s = row & 2047; const float pr = (float)(s >> 6), pc = (float)(s & 63);
                    float ss = 0.f;
#pragma unroll
                    for (int bj = 0; bj < 2; ++bj)
#pragma unroll
                        for (int n = 0; n < 2; ++n) { const f32x4 v = acc[ai][bj][m][n] + *(const f32x4*)(bp + bj * 32 + 4 * n); ss += (v[0] * v[0] + v[1] * v[1]) + (v[2] * v[2] + v[3] * v[3]); }
                    ss += __shfl_xor(ss, 16); ss += __shfl_xor(ss, 32);
                    const float rs = __builtin_amdgcn_rsqf(ss * (1.0f / 64.0f) + 1e-6f);
                    bf16_t* rowp = dst + (size_t)row * pitch + dcol;
#pragma unroll
                    for (int bj = 0; bj < 2; ++bj) { const float pos = bj ? pc : pr; u32x4 w;
#pragma unroll
                        for (int n = 0; n < 2; ++n) { const f32x4 v = (acc[ai][bj][m][n] + *(const f32x4*)(bp + bj * 32 + 4 * n)) * rs * *(const f32x4*)(gp + bj * 32 + 4 * n);
#pragma unroll
                            for (int h = 0; h < 2; ++h) { const float fr_ = __builtin_amdgcn_exp2f(-(float)(4 * fqo + 2 * n + h) * 0.8304820237218407f) * 0.15915494309189535f;
                                const float ang = pos * fr_; const float c = __builtin_amdgcn_cosf(ang), sn = __builtin_amdgcn_sinf(ang);
                                w[2 * n + h] = cvt_pk_bf16((v[2 * h] * c - v[2 * h + 1] * sn) * sc, (v[2 * h] * sn + v[2 * h + 1] * c) * sc); } }
                        *(u32x4*)(rowp + bj * 32) = w; }
                    __builtin_amdgcn_sched_barrier(0);
                }
        } else {
#pragma unroll
            for (int ai = 0; ai < 2; ++ai)
#pragma unroll
                for (int m = 0; m < 4; ++m) { bf16_t* rowp = dst + (size_t)(row0 + ai * HALF + m * 16) * pitch + dcol;
#pragma unroll
                    for (int bj = 0; bj < 2; ++bj) { f32x4 v0 = acc[ai][bj][m][0] + bv[bj][0], v1 = acc[ai][bj][m][1] + bv[bj][1];
                        if (type == 1) {
#pragma unroll
                            for (int e = 0; e < 4; ++e) { v0[e] *= sigmoid_f(v0[e]); v1[e] *= sigmoid_f(v1[e]); } }
                        else { v0 = v0 * sc; v1 = v1 * sc; }
                        u32x4 w; w.x = cvt_pk_bf16(v0[0], v0[1]); w.y = cvt_pk_bf16(v0[2], v0[3]); w.z = cvt_pk_bf16(v1[0], v1[1]); w.w = cvt_pk_bf16(v1[2], v1[3]);
                        *(u32x4*)(rowp + bj * 32) = w; } }
        }
    }
};

struct EpiGate {
    static constexpr bool PERM = true, AFTER_DRAIN = false, MIDHOOK = false;
    bf16_t* G; const float* biasv;
    __device__ __forceinline__ void operator()(const f32x4 (&acc)[2][2][4][2], const Unit& u, int wr, int wc, int fr, int fq) const {
        const int vc0 = u.pn * 256 + wc * 64 + fq * 8;
        f32x4 bv[2][2];
#pragma unroll
        for (int bj = 0; bj < 2; ++bj)
#pragma unroll
            for (int n = 0; n < 2; ++n) bv[bj][n] = *(const f32x4*)(biasv + vc0 + bj * 32 + 4 * n);
        const int row0 = u.pm * BM + wr * 64 + fr;
#pragma unroll
        for (int ai = 0; ai < 2; ++ai)
#pragma unroll
            for (int m = 0; m < 4; ++m) { bf16_t* rowp = G + (size_t)(row0 + ai * HALF + m * 16) * 3072 + vc0;
#pragma unroll
                for (int bj = 0; bj < 2; ++bj) { f32x4 v0 = acc[ai][bj][m][0] + bv[bj][0], v1 = acc[ai][bj][m][1] + bv[bj][1];
#pragma unroll
                    for (int e = 0; e < 4; ++e) { v0[e] = fmaxf(sigmoid_f(v0[e]), 1e-30f); v1[e] = fmaxf(sigmoid_f(v1[e]), 1e-30f); }
                    u32x4 w; w.x = cvt_pk_bf16(v0[0], v0[1]); w.y = cvt_pk_bf16(v0[2], v0[3]); w.z = cvt_pk_bf16(v1[0], v1[1]); w.w = cvt_pk_bf16(v1[2], v1[3]);
                    *(u32x4*)(rowp + bj * 32) = w; } }
    }
};

struct EpiMerge {
    static constexpr bool PERM = true, AFTER_DRAIN = false, MIDHOOK = true;
    const bf16_t* G; bf16_t* O;
    __device__ __forceinline__ void mid(f32x4 (&acc)[2][2][4][2], const Unit& u, int seg, int wr, int wc, int fr, int fq) const {
        const int row0 = u.pm * BM + wr * 64 + fr, col0 = u.pn * BM + wc * 32 + 8 * fq;
        const bf16_t* gp = G + (size_t)row0 * 3072 + (seg - 1) * 1024 + col0;
#pragma unroll
        for (int ai = 0; ai < 2; ++ai)
#pragma unroll
            for (int m = 0; m < 4; ++m)
#pragma unroll
                for (int bj = 0; bj < 2; ++bj) { const bf16_t* p = gp + (size_t)(ai * HALF + m * 16) * 3072 + bj * HALF;
                    const u32x4 ga = *(const u32x4*)p, gb = *(const u32x4*)(p + 1024);
#pragma unroll
                    for (int e = 0; e < 2; ++e) {
                        acc[ai][bj][m][0][2 * e] *= bf_lo(ga[e]) * __builtin_amdgcn_rcpf(bf_lo(gb[e])); acc[ai][bj][m][0][2 * e + 1] *= bf_hi(ga[e]) * __builtin_amdgcn_rcpf(bf_hi(gb[e]));
                        acc[ai][bj][m][1][2 * e] *= bf_lo(ga[2 + e]) * __builtin_amdgcn_rcpf(bf_lo(gb[2 + e])); acc[ai][bj][m][1][2 * e + 1] *= bf_hi(ga[2 + e]) * __builtin_amdgcn_rcpf(bf_hi(gb[2 + e])); } }
    }
    __device__ __forceinline__ void operator()(const f32x4 (&acc)[2][2][4][2], const Unit& u, int wr, int wc, int fr, int fq) const {
        const int row0 = u.pm * BM + wr * 64 + fr, col0 = u.pn * BM + wc * 32 + 8 * fq;
#pragma unroll
        for (int ai = 0; ai < 2; ++ai)
#pragma unroll
            for (int m = 0; m < 4; ++m)
#pragma unroll
                for (int bj = 0; bj < 2; ++bj) { const size_t r = (size_t)(row0 + ai * HALF + m * 16);
                    const u32x4 g2 = *(const u32x4*)(G + r * 3072 + 2048 + col0 + bj * HALF);
                    const f32x4 a0 = acc[ai][bj][m][0], a1 = acc[ai][bj][m][1]; u32x4 w;
                    w.x = cvt_pk_bf16(a0[0] * bf_lo(g2.x), a0[1] * bf_hi(g2.x)); w.y = cvt_pk_bf16(a0[2] * bf_lo(g2.y), a0[3] * bf_hi(g2.y));
                    w.z = cvt_pk_bf16(a1[0] * bf_lo(g2.z), a1[1] * bf_hi(g2.z)); w.w = cvt_pk_bf16(a1[2] * bf_lo(g2.w), a1[3] * bf_hi(g2.w));
                    *(u32x4*)(O + r * 1024 + col0 + bj * HALF) = w; }
    }
};

struct EpiOut {
    static constexpr bool PERM = false, AFTER_DRAIN = false, MIDHOOK = false;
    float* H; const float* bias; float alpha; bool wr_en;
    __device__ __forceinline__ void operator()(const f32x4 (&acc)[2][2][4][2], const Unit& u, int wr, int wc, int fr, int fq) const {
        const int row0 = u.pm * BM + wr * 64 + fr, col0 = u.pn * BM + wc * 32 + 4 * fq;
        f32x4 bv[2][2];
#pragma unroll
        for (int bj = 0; bj < 2; ++bj)
#pragma unroll
            for (int n = 0; n < 2; ++n) bv[bj][n] = *(const f32x4*)(bias + col0 + bj * HALF + n * 16);
#pragma unroll
        for (int ai = 0; ai < 2; ++ai)
#pragma unroll
            for (int m = 0; m < 4; ++m) { float* rowp = H + (size_t)(row0 + ai * HALF + m * 16) * 1024 + col0;
#pragma unroll
                for (int bj = 0; bj < 2; ++bj)
#pragma unroll
                    for (int n = 0; n < 2; ++n) { float* p = rowp + bj * HALF + n * 16; const f32x4 hv = *(const f32x4*)p; const f32x4 r_ = hv * alpha + acc[ai][bj][m][n] + bv[bj][n]; if (wr_en) *(f32x4*)p = r_; } }
    }
};
template <class Epi, class Sched, bool ALIGN_EPI = false, bool SP2 = false>
__device__ __forceinline__ void gemm_phase(PG8_LAS unsigned char* lds, const Gemm g, const Sched& S, const Epi& E) {
    int tid_ = threadIdx.x; asm volatile("" : "+v"(tid_));
    const int tid = tid_, wid = __builtin_amdgcn_readfirstlane(tid >> 6), lane = tid & 63, wr = wid >> 2, wc = wid & 3, fr = lane & 15, fq = lane >> 4;
    const int K = g.K, nt = K / BK;
    unsigned voffA[2], voffB[2];
#pragma unroll
    for (int i = 0; i < 2; ++i) { int R, C; stage_rc(tid * 16 + i * 8192, R, C); const int Rb = Epi::PERM ? ((R & ~31) + perm32(R & 31)) : R;
        voffA[i] = (unsigned)(R * g.lda + C) * 2u; voffB[i] = (unsigned)(Rb * g.ldb + C) * 2u; }
    const size_t kstep = (size_t)(BK * 2);
    const size_t hstepA = (size_t)HALF * g.lda * 2, hstepB = (size_t)HALF * g.ldb * 2;
    const size_t tstepA = 2 * hstepA, tstepB = 2 * hstepB;
    const unsigned ldsw = (unsigned)wid * 1024u;
    const int aoff = lds_byte(wr * 64 + fr, fq * 8), boff = lds_byte(wc * 32 + fr, fq * 8);
#define PG8_SA(b, h) (((b) * 2 + (h)) * HTB)
#define PG8_SB(b, h) ((4 + (b) * 2 + (h)) * HTB)
#define PG8_STAGE(bufoff, gbase, voff) do { _Pragma("unroll") for (int _i = 0; _i < 2; ++_i) \
        __builtin_amdgcn_global_load_lds((const unsigned*)((const char*)(gbase) + (voff)[_i]), (PG8_LAS unsigned*)(lds + (bufoff) + ldsw + _i * 8192), 16, 0, 0); } while (0)
#define PG8_LDA(dst, b, h) do { _Pragma("unroll") for (int m = 0; m < 4; ++m) _Pragma("unroll") for (int k = 0; k < 2; ++k) dst[m][k] = *(const PG8_LAS bf16x8*)(lds + PG8_SA(b, h) + aoff + m * 2048 + k * 1024); } while (0)
#define PG8_LDB(dst, b, h) do { _Pragma("unroll") for (int n = 0; n < 2; ++n) _Pragma("unroll") for (int k = 0; k < 2; ++k) dst[n][k] = *(const PG8_LAS bf16x8*)(lds + PG8_SB(b, h) + boff + n * 2048 + k * 1024); } while (0)
#define PG8_MMA(ai, bj, At, Bt) do { __builtin_amdgcn_s_setprio(1); _Pragma("unroll") for (int m = 0; m < 4; ++m) _Pragma("unroll") for (int n = 0; n < 2; ++n) _Pragma("unroll") for (int k = 0; k < 2; ++k) \
        acc[ai][bj][m][n] = __builtin_amdgcn_mfma_f32_16x16x32_bf16(Bt[n][k], At[m][k], acc[ai][bj][m][n], 0, 0, 0); __builtin_amdgcn_s_setprio(0); } while (0)
#define PG8_WAIT_V(n) asm volatile("s_waitcnt vmcnt(" #n ")" ::: "memory")
#define PG8_WAIT_L(n) asm volatile("s_waitcnt lgkmcnt(" #n ")" ::: "memory")
#define PG8_BAR __builtin_amdgcn_s_barrier()
#define PG8_SCHED __builtin_amdgcn_sched_barrier(0)
    Unit cur, nxt; int ui = 0;
    if (!S.next(0, cur)) return;
    f32x4 acc[2][2][4][2];
#pragma unroll
    for (int a = 0; a < 2; ++a)
#pragma unroll
        for (int b = 0; b < 2; ++b)
#pragma unroll
            for (int m = 0; m < 4; ++m)
#pragma unroll
                for (int n = 0; n < 2; ++n) acc[a][b][m][n] = (f32x4){0.f, 0.f, 0.f, 0.f};
    bf16x8 At[4][2], B0[2][2], B1[2][2];
    const char* cA = (const char*)g.A + (size_t)cur.pm * tstepA; const char* cB = (const char*)g.Bt + (size_t)cur.pn * tstepB;
    S.a_ready(cur);
    if constexpr (SP2) {
        PG8_STAGE(PG8_SB(0, 0), cB, voffB); PG8_STAGE(PG8_SB(0, 1), cB + hstepB, voffB); PG8_STAGE(PG8_SA(0, 0), cA, voffA); PG8_STAGE(PG8_SA(0, 1), cA + hstepA, voffA);
        if (wr == 1) PG8_BAR;
        PG8_WAIT_V(2); PG8_BAR;
        PG8_STAGE(PG8_SB(1, 0), cB + kstep, voffB); PG8_STAGE(PG8_SA(1, 0), cA + kstep, voffA); PG8_STAGE(PG8_SB(1, 1), cB + hstepB + kstep, voffB);
        PG8_WAIT_V(6); PG8_BAR;
    } else {
        PG8_STAGE(PG8_SB(0, 0), cB, voffB); PG8_STAGE(PG8_SA(0, 0), cA, voffA); PG8_STAGE(PG8_SB(0, 1), cB + hstepB, voffB); PG8_STAGE(PG8_SA(0, 1), cA + hstepA, voffA);
        if (wr == 1) PG8_BAR;
        PG8_WAIT_V(4); PG8_BAR;
        PG8_STAGE(PG8_SB(1, 0), cB + kstep, voffB); PG8_STAGE(PG8_SA(1, 0), cA + kstep, voffA); PG8_STAGE(PG8_SB(1, 1), cB + hstepB + kstep, voffB);
        PG8_WAIT_V(6); PG8_BAR;
    }
    for (;;) {
        const bool has_next = S.next(ui + 1, nxt);
        const char* nA = has_next ? (const char*)g.A + (size_t)nxt.pm * tstepA : cA; const char* nB = has_next ? (const char*)g.Bt + (size_t)nxt.pn * tstepB : cB;
        for (int t = 0; t < nt; t += 2) {
            const bool last = (t == nt - 2);
            const char* a1 = cA + (size_t)(t + 1) * kstep;
            const char* a2 = last ? nA : cA + (size_t)(t + 2) * kstep; const char* b2 = last ? nB : cB + (size_t)(t + 2) * kstep;
            const char* a3 = a2 + kstep; const char* b3 = b2 + kstep;
            if (last && has_next) S.a_ready(nxt);
            if constexpr (Epi::MIDHOOK) { if (t == 8 || t == 16) E.mid(acc, cur, t >> 3, wr, wc, fr, fq); }
            if constexpr (SP2) {
            PG8_LDB(B0, 0, 0); PG8_LDB(B1, 0, 1); PG8_SCHED; PG8_LDA(At, 0, 0); PG8_STAGE(PG8_SA(1, 1), a1 + hstepA, voffA);
            PG8_WAIT_V(8); PG8_WAIT_L(0); PG8_BAR; PG8_MMA(0, 0, At, B0); PG8_MMA(0, 1, At, B1); PG8_BAR; PG8_SCHED;
            PG8_LDA(At, 0, 1); PG8_STAGE(PG8_SB(0, 0), b2, voffB); PG8_STAGE(PG8_SB(0, 1), b2 + hstepB, voffB); PG8_STAGE(PG8_SA(0, 0), a2, voffA);
            PG8_WAIT_V(8); PG8_WAIT_L(0); PG8_BAR; PG8_MMA(1, 0, At, B0); PG8_MMA(1, 1, At, B1); PG8_BAR; PG8_SCHED;
            PG8_LDB(B0, 1, 0); PG8_LDB(B1, 1, 1); PG8_SCHED; PG8_LDA(At, 1, 0); PG8_STAGE(PG8_SA(0, 1), a2 + hstepA, voffA);
            PG8_WAIT_V(8); PG8_WAIT_L(0); PG8_BAR; PG8_MMA(0, 0, At, B0); PG8_MMA(0, 1, At, B1); PG8_BAR; PG8_SCHED;
            PG8_LDA(At, 1, 1); PG8_STAGE(PG8_SB(1, 0), b3, voffB); PG8_STAGE(PG8_SB(1, 1), b3 + hstepB, voffB); PG8_STAGE(PG8_SA(1, 0), a3, voffA);
            PG8_WAIT_V(8); PG8_WAIT_L(0); PG8_BAR; PG8_MMA(1, 0, At, B0); PG8_MMA(1, 1, At, B1); PG8_BAR; PG8_SCHED;
            } else {
            PG8_LDB(B0, 0, 0); PG8_SCHED; PG8_LDA(At, 0, 0); PG8_STAGE(PG8_SA(1, 1), a1 + hstepA, voffA);
            PG8_WAIT_L(8); PG8_BAR; PG8_WAIT_L(0); PG8_MMA(0, 0, At, B0); PG8_BAR; PG8_SCHED;
            PG8_LDB(B1, 0, 1); PG8_STAGE(PG8_SB(0, 0), b2, voffB);
            PG8_BAR; PG8_WAIT_L(0); PG8_MMA(0, 1, At, B1); PG8_BAR;
            PG8_LDA(At, 0, 1); PG8_STAGE(PG8_SA(0, 0), a2, voffA);
            PG8_BAR; PG8_WAIT_L(0); PG8_MMA(1, 0, At, B0); PG8_BAR; PG8_SCHED;
            PG8_STAGE(PG8_SB(0, 1), b2 + hstepB, voffB);
            PG8_WAIT_V(6); PG8_BAR; PG8_MMA(1, 1, At, B1); PG8_BAR;
            PG8_LDB(B0, 1, 0); PG8_SCHED; PG8_LDA(At, 1, 0); PG8_STAGE(PG8_SA(0, 1), a2 + hstepA, voffA);
            PG8_WAIT_L(8); PG8_BAR; PG8_WAIT_L(0); PG8_MMA(0, 0, At, B0); PG8_BAR; PG8_SCHED;
            PG8_LDB(B1, 1, 1); PG8_STAGE(PG8_SB(1, 0), b3, voffB);
            PG8_BAR; PG8_WAIT_L(0); PG8_MMA(0, 1, At, B1); PG8_BAR;
            PG8_LDA(At, 1, 1); PG8_STAGE(PG8_SA(1, 0), a3, voffA);
            PG8_BAR; PG8_WAIT_L(0); PG8_MMA(1, 0, At, B0); PG8_BAR; PG8_SCHED;
            PG8_STAGE(PG8_SB(1, 1), b3 + hstepB, voffB);
            PG8_WAIT_V(6); PG8_BAR; PG8_MMA(1, 1, At, B1); PG8_BAR;
            }
        }
        if constexpr (ALIGN_EPI) { if (wr == 0) PG8_BAR; }
        if constexpr (!Epi::AFTER_DRAIN) { E(acc, cur, wr, wc, fr, fq); S.done(cur); }
        if (!has_next) break;
#pragma unroll
        for (int a = 0; a < 2; ++a)
#pragma unroll
            for (int b = 0; b < 2; ++b)
#pragma unroll
                for (int m = 0; m < 4; ++m)
#pragma unroll
                    for (int n = 0; n < 2; ++n) acc[a][b][m][n] = (f32x4){0.f, 0.f, 0.f, 0.f};
        cur = nxt; cA = nA; cB = nB; ++ui;
        if constexpr (ALIGN_EPI) { if (wr == 1) PG8_BAR; }
    }
    PG8_WAIT_V(0);
    if constexpr (!ALIGN_EPI) { if (wr == 0) PG8_BAR; }
    PG8_BAR;
    if constexpr (Epi::AFTER_DRAIN) { E.fused(acc, cur, wr, wc, fr, fq, lds, wid, lane); S.done(cur); }
#undef PG8_SA
#undef PG8_SB
#undef PG8_STAGE
#undef PG8_LDA
#undef PG8_LDB
#undef PG8_MMA
#undef PG8_WAIT_V
#undef PG8_WAIT_L
#undef PG8_BAR
#undef PG8_SCHED
}
}
#include <hip/hip_bf16.h>
#include <cmath>
namespace attn_body {
using bf16=__hip_bfloat16;
using bf16x8=__attribute__((ext_vector_type(8)))short;
using s16x4=__attribute__((ext_vector_type(4)))short;
using f32x16=__attribute__((ext_vector_type(16)))float;
using u32x4=__attribute__((ext_vector_type(4)))unsigned;
constexpr int BATCH=8,NHEAD=8,SEQ=2048,D=64,QP=1536,KP=3328;
constexpr int NW=8,QBLK=32,QB=QBLK*NW,KVBLK=64,NQB=SEQ/QB;
constexpr int ATTN_UNIT_ROWS=QB;
__device__ __forceinline__ int crow(int r,int hi){return (r&3)+8*(r>>2)+4*hi;}
#define SBAR() __builtin_amdgcn_sched_barrier(0)
__device__ __forceinline__ void cmask(f32x16&p0,f32x16&p1,int jb,int qrel,int hi){
  const float NEG=-INFINITY; int kb=64*jb+4*hi;
  #pragma unroll
  for(int r=0;r<16;++r){int kv=kb+(r&3)+8*(r>>2); if(kv>qrel)p0[r]=NEG; if(kv+32>qrel)p1[r]=NEG;}
}

constexpr int NSLOT=3, SLOTB=8192;
constexpr int LDS_K=0, LDS_V=NSLOT*SLOTB, LDS_WS=2*NSLOT*SLOTB, LDS_OST=LDS_WS+NW*64*4, LDS_BYTES=LDS_OST+NW*4096;
constexpr float C2=0.125f*1.4426950408889634f;
__device__ __forceinline__ void glds16(const void*gsrc,unsigned lds_dst){unsigned keep;
  asm volatile("s_mov_b32 %0, m0\n\ts_mov_b32 m0, %2\n\ts_nop 0\n\tglobal_load_lds_dwordx4 %1, off\n\ts_mov_b32 m0, %0":"=&s"(keep):"v"(gsrc),"s"(lds_dst):"memory");}
__device__ __forceinline__ float max3f(float a,float b,float c){float r;asm("v_max3_f32 %0, %1, %2, %3":"=v"(r):"v"(a),"v"(b),"v"(c));return r;}
__device__ __forceinline__ float max2f(float a,float b){float r;asm("v_max_f32_e32 %0, %1, %2":"=v"(r):"v"(a),"v"(b));return r;}
__device__ __forceinline__ float fadd_s(float a,float b){float r;asm("v_add_f32_e32 %0, %1, %2":"=v"(r):"v"(a),"v"(b));return r;}
__device__ __forceinline__ float fsub_s(float a,float b){float r;asm("v_sub_f32_e32 %0, %1, %2":"=v"(r):"v"(a),"v"(b));return r;}
typedef float f32x2_t __attribute__((ext_vector_type(2))); typedef __bf16 bf16x2_t __attribute__((ext_vector_type(2)));
__device__ __forceinline__ unsigned cvtpk_s(float lo,float hi){f32x2_t v={lo,hi};bf16x2_t b=__builtin_convertvector(v,bf16x2_t);return __builtin_bit_cast(unsigned,b);}
#define WAIT_BAR(N) asm volatile("s_waitcnt vmcnt(" #N ") lgkmcnt(0)\n\ts_barrier":::"memory")

__device__ __forceinline__ void qkt(f32x16&p0,f32x16&p1,const char*Kslot,const bf16x8*qr,const f32x16&negm,int r32,int hi){
  const char*kb=Kslot+hi*1024+r32*16;
  #pragma unroll
  for(int d0=0;d0<4;++d0){
    const bf16x8 b0=*reinterpret_cast<const bf16x8*>(kb+d0*2048);
    const bf16x8 b1=*reinterpret_cast<const bf16x8*>(kb+d0*2048+512);
    if(d0==0){p0=__builtin_amdgcn_mfma_f32_32x32x16_bf16(b0,qr[0],negm,0,0,0);p1=__builtin_amdgcn_mfma_f32_32x32x16_bf16(b1,qr[0],negm,0,0,0);}
    else{p0=__builtin_amdgcn_mfma_f32_32x32x16_bf16(b0,qr[d0],p0,0,0,0);p1=__builtin_amdgcn_mfma_f32_32x32x16_bf16(b1,qr[d0],p1,0,0,0);}}
}
typedef __attribute__((address_space(3))) const char* lds_cptr;
typedef short v4i16_t __attribute__((ext_vector_type(4)));
__device__ __forceinline__ void kload8(bf16x8*kf,lds_cptr kp){
  kf[0]=*(const __attribute__((address_space(3))) bf16x8*)(kp);      kf[1]=*(const __attribute__((address_space(3))) bf16x8*)(kp+512);
  kf[2]=*(const __attribute__((address_space(3))) bf16x8*)(kp+2048); kf[3]=*(const __attribute__((address_space(3))) bf16x8*)(kp+2560);
  kf[4]=*(const __attribute__((address_space(3))) bf16x8*)(kp+4096); kf[5]=*(const __attribute__((address_space(3))) bf16x8*)(kp+4608);
  kf[6]=*(const __attribute__((address_space(3))) bf16x8*)(kp+6144); kf[7]=*(const __attribute__((address_space(3))) bf16x8*)(kp+6656);
}
__device__ __forceinline__ void kload2(bf16x8*kf,lds_cptr kp,int j){ kf[2*j]=*(const __attribute__((address_space(3))) bf16x8*)(kp+j*2048); kf[2*j+1]=*(const __attribute__((address_space(3))) bf16x8*)(kp+j*2048+512); }
__device__ __forceinline__ s16x4 vtr(lds_cptr p){ return __builtin_bit_cast(s16x4,__builtin_amdgcn_ds_read_tr16_b64_v4i16((__attribute__((address_space(3))) v4i16_t*)p)); }
__device__ __forceinline__ float rowmax(const f32x16&p0,const f32x16&p1){
  float a=max3f(p0[0],p0[1],p1[0]),b=max3f(p0[2],p0[3],p1[1]);a=max3f(a,p1[2],p1[3]);
  #pragma unroll
  for(int r=4;r<16;r+=4){a=max3f(a,p0[r],p0[r+1]);b=max3f(b,p0[r+2],p0[r+3]);a=max3f(a,p1[r],p1[r+1]);b=max3f(b,p1[r+2],p1[r+3]);}
  const float m=max2f(a,b);
  auto rr=__builtin_amdgcn_permlane32_swap(__float_as_uint(m),__float_as_uint(m),false,false);
  return max2f(__uint_as_float(rr[0]),__uint_as_float(rr[1]));
}
__device__ __forceinline__ void pv(f32x16*o,int vb,bf16x8 pa0,bf16x8 pa1,bf16x8 pa2,bf16x8 pa3){
  #pragma unroll
  for(int d0=0;d0<2;++d0){s16x4 lo[4],hi[4];
    #pragma unroll
    for(int ks=0;ks<4;++ks){
      asm volatile("ds_read_b64_tr_b16 %0,%1 offset:%c2":"=&v"(lo[ks]):"v"(vb),"i"(d0*4096+ks*1024):"memory");
      asm volatile("ds_read_b64_tr_b16 %0,%1 offset:%c2":"=&v"(hi[ks]):"v"(vb),"i"(d0*4096+ks*1024+512):"memory");}
    asm volatile("s_waitcnt lgkmcnt(0)":::"memory");SBAR();
    #define PK(k) (bf16x8){lo[k][0],lo[k][1],lo[k][2],lo[k][3],hi[k][0],hi[k][1],hi[k][2],hi[k][3]}
    o[d0]=__builtin_amdgcn_mfma_f32_32x32x16_bf16(pa0,PK(0),o[d0],0,0,0);
    o[d0]=__builtin_amdgcn_mfma_f32_32x32x16_bf16(pa1,PK(1),o[d0],0,0,0);
    o[d0]=__builtin_amdgcn_mfma_f32_32x32x16_bf16(pa2,PK(2),o[d0],0,0,0);
    o[d0]=__builtin_amdgcn_mfma_f32_32x32x16_bf16(pa3,PK(3),o[d0],0,0,0);
    #undef PK
  }
}

#ifndef ATTN_STORE16
#define ATTN_STORE16(p,v) (*(u32x4*)(p)=(v))
#endif
template<int THRL> __device__ __forceinline__ void attn_unit(int b,int h,int kvh,int qb,const bf16*Q,const bf16*__restrict__ K,const bf16*__restrict__ V,const bf16*__restrict__ Z,bf16*O,char*shm,bool wr_en){
  int tid_=threadIdx.x; asm volatile("":"+v"(tid_)); const int tid=tid_,lane=tid&63,r32=lane&31,hi=lane>>5; const int wid=__builtin_amdgcn_readfirstlane(tid>>6);
  const long rowbase=(long)b*SEQ; const int q0=qb*QB;
  const bf16*Qw=Q+(rowbase+q0+wid*QBLK)*QP+h*D;
  const bf16*Kh=K+rowbase*KP+kvh*D,*Vh=V+rowbase*KP+kvh*D;
  const unsigned lds0=(unsigned)(uintptr_t)shm;
  float*wsf=(float*)(shm+LDS_WS)+wid*64;
  const bf16*ksrc=Kh+(long)lane*KP+wid*8;
  const bf16*vsrc=Vh+(long)(16*(wid&3)+(lane>>2))*KP+(wid>>2)*32+(lane&3)*8;
  const unsigned kdst=lds0+LDS_K+wid*1024, vdst=lds0+LDS_V+wid*1024;
  #define DMA_K(t,slot) glds16(ksrc+(long)(t)*KVBLK*KP,(unsigned)__builtin_amdgcn_readfirstlane(kdst+(slot)))
  #define DMA_V(t,slot) glds16(vsrc+(long)(t)*KVBLK*KP,(unsigned)__builtin_amdgcn_readfirstlane(vdst+(slot)))
  const int vb0=(int)(lds0+LDS_V)+((lane>>4)&1)*32+(lane&3)*8+(4*hi+((lane&15)>>2))*64;
  const char*Kbase=shm+LDS_K; bf16x8 kf[8];
  const lds_cptr shm3=(lds_cptr)shm; const lds_cptr kp0=shm3+LDS_K+hi*1024+r32*16; const lds_cptr vp0=shm3+LDS_V+((lane>>4)&1)*32+(lane&3)*8+(4*hi+((lane&15)>>2))*64;
  const int NT=SEQ/KVBLK;
  DMA_K(0,0);DMA_V(0,0);DMA_K(1,SLOTB);
  bf16x8 qr[4];
  #pragma unroll
  for(int d0=0;d0<4;++d0)qr[d0]=*reinterpret_cast<const bf16x8*>(&Qw[(long)r32*QP+d0*16+hi*8]);
  float mhat=0.f,l_reg=0.f;f32x16 o[2];o[0]=f32x16{};o[1]=f32x16{};f32x16 negm=f32x16{};asm volatile("":"+v"(negm));

  #define CMASK(P0,P1,t) do{}while(0)
  bool resc=false;
  #define START(P0,P1) do{ const float rm=rowmax(P0,P1); resc=false; \
    { const float dl=rm; mhat=fadd_s(mhat,dl); \
      _Pragma("unroll") for(int r=0;r<16;++r){P0[r]=fsub_s(P0[r],dl);P1[r]=fsub_s(P1[r],dl);} \
      _Pragma("unroll") for(int r=0;r<16;++r)negm[r]=-mhat; asm volatile("":"+v"(negm)); } \
    _Pragma("unroll") for(int r=0;r<16;++r)P0[r]=__builtin_amdgcn_exp2f(P0[r]); }while(0)
  #define RESC() do{ if(resc){ asm volatile("s_waitcnt lgkmcnt(0)":::"memory"); \
      _Pragma("unroll") for(int d_=0;d_<2;++d_) _Pragma("unroll") for(int r=0;r<16;++r)o[d_][r]*=wsf[crow(r,hi)]; } }while(0)
  f32x16 pA0,pA1,pB0,pB1;
  int sl_prev=0,sl_cur=0,sl_next=SLOTB;
  #define ROT() do{sl_prev=sl_cur;sl_cur=sl_next;sl_next=(sl_next==(NSLOT-1)*SLOTB)?0:sl_next+SLOTB;}while(0)
  DMA_K(2,2*SLOTB);
  WAIT_BAR(3);
  qkt(pA0,pA1,Kbase,qr,negm,r32,hi);asm volatile("s_nop 15\n\ts_nop 7":"+v"(pA0),"+v"(pA1));CMASK(pA0,pA1,0);
  START(pA0,pA1);
  _Pragma("unroll") for(int r=0;r<16;++r)pA1[r]=__builtin_amdgcn_exp2f(pA1[r]);
  WAIT_BAR(0);
  DMA_K(3,0);DMA_V(1,SLOTB);
  ROT();
  kload8(kf,kp0+sl_cur);
  WAIT_BAR(2);
  s16x4 vlo[8],vhi[8]; u32x4 pw0,pw1,pw2,pw3;
  #define PKW(P,B) cvtpk_s(P[B],P[B+1])
  #define PAF(k) __builtin_bit_cast(bf16x8,pw##k)
  #define VFR(i) (bf16x8){vlo[i][0],vlo[i][1],vlo[i][2],vlo[i][3],vhi[i][0],vhi[i][1],vhi[i][2],vhi[i][3]}
  #define PIN(x) asm volatile("":"+v"(x))
  #define MX3(a,b,c) __builtin_fmaxf(__builtin_fmaxf((a),(b)),(c))
  #define GAPA(MF,A0,A1,A2,A3,W0,W1,PW) do{ MF; sacc+=A0; sacc+=A1; sacc+=A2; sacc+=A3; PIN(sacc); W0; W1; PIN(PW); SBAR(); }while(0)
  #define EX(v) __builtin_amdgcn_exp2f(v)
  #define GAPB(MF,X,B) do{ MF; X[B]=EX(X[B]); X[B+1]=EX(X[B+1]); X[B+2]=EX(X[B+2]); X[B+3]=EX(X[B+3]); PIN(X); SBAR(); }while(0)
  #define VRD(i) do{ vlo[i]=vtr(vp_+(((i)>>2)*4096+((i)&3)*1024)); vhi[i]=vtr(vp_+(((i)>>2)*4096+((i)&3)*1024+512)); }while(0)
  #define KRD(G,j) do{ if(G){ kload2(kf,kp0+sl_next,j); SBAR(); } }while(0)
  #define STEP(C0,C1,P0,P1,t,GK,GV,GL) do{ SBAR(); \
    const lds_cptr vp_=vp0+sl_prev; \
    VRD(0); SBAR(); float sacc=(P0[0]+P0[1]); \
    GAPA(C0=__builtin_amdgcn_mfma_f32_32x32x16_bf16(kf[0],qr[0],negm,0,0,0), P0[2],P0[3],P0[4],P0[5],     pw0[0]=PKW(P0,0), pw0[1]=PKW(P0,2), pw0); \
    VRD(4); SBAR(); GAPA(C1=__builtin_amdgcn_mfma_f32_32x32x16_bf16(kf[1],qr[0],negm,0,0,0), P0[6],P0[7],P0[8],P0[9],     pw0[2]=PKW(P0,4), pw0[3]=PKW(P0,6), pw0); \
    VRD(1); SBAR(); GAPA(C0=__builtin_amdgcn_mfma_f32_32x32x16_bf16(kf[2],qr[1],C0,0,0,0),   P0[10],P0[11],P0[12],P0[13], pw1[0]=PKW(P0,8), pw1[1]=PKW(P0,10), pw1); \
    VRD(5); SBAR(); GAPA(C1=__builtin_amdgcn_mfma_f32_32x32x16_bf16(kf[3],qr[1],C1,0,0,0),   P0[14],P0[15],P1[0],P1[1],   pw1[2]=PKW(P0,12),pw1[3]=PKW(P0,14), pw1); \
    VRD(2); SBAR(); GAPA(C0=__builtin_amdgcn_mfma_f32_32x32x16_bf16(kf[4],qr[2],C0,0,0,0),   P1[2],P1[3],P1[4],P1[5],     pw2[0]=PKW(P1,0), pw2[1]=PKW(P1,2), pw2); \
    VRD(6); SBAR(); GAPA(C1=__builtin_amdgcn_mfma_f32_32x32x16_bf16(kf[5],qr[2],C1,0,0,0),   P1[6],P1[7],P1[8],P1[9],     pw2[2]=PKW(P1,4), pw2[3]=PKW(P1,6), pw2); \
    VRD(3); SBAR(); GAPA(C0=__builtin_amdgcn_mfma_f32_32x32x16_bf16(kf[6],qr[3],C0,0,0,0),   P1[10],P1[11],P1[12],P1[13], pw3[0]=PKW(P1,8), pw3[1]=PKW(P1,10), pw3); \
    VRD(7); SBAR(); GAPA(C1=__builtin_amdgcn_mfma_f32_32x32x16_bf16(kf[7],qr[3],C1,0,0,0),   P1[14],P1[15],0.f,0.f,       pw3[2]=PKW(P1,12),pw3[3]=PKW(P1,14), pw3); \
    l_reg+=sacc; \
    if(GK){DMA_K((t)+3,sl_cur);} if(GV){DMA_V((t)+1,sl_next);} \
    CMASK(C0,C1,t); \
    { float a=MX3(C0[0],C0[1],C1[0]),b=MX3(C0[2],C0[3],C1[1]); a=MX3(a,C1[2],C1[3]); \
      _Pragma("unroll") for(int r=4;r<16;r+=4){a=MX3(a,C0[r],C0[r+1]);b=MX3(b,C0[r+2],C0[r+3]);a=MX3(a,C1[r],C1[r+1]);b=MX3(b,C1[r+2],C1[r+3]);} \
      float rm=__builtin_fmaxf(a,b); { auto rr=__builtin_amdgcn_permlane32_swap(__float_as_uint(rm),__float_as_uint(rm),false,false); rm=__builtin_fmaxf(__uint_as_float(rr[0]),__uint_as_float(rr[1])); } \
      resc=false; \
      if(__builtin_expect(__any(rm>(float)THRL),0)){ const float dl=__builtin_fmaxf(rm,0.f); mhat+=dl; \
        _Pragma("unroll") for(int r=0;r<16;++r){C0[r]-=dl;C1[r]-=dl;} \
        _Pragma("unroll") for(int r=0;r<16;++r)negm[r]=-mhat; asm volatile("":"+v"(negm)); \
        const float f=__builtin_amdgcn_exp2f(-dl); l_reg*=f; if(hi==0)wsf[r32]=f; resc=true; } } \
    SBAR(); \
    GAPB(o[0]=__builtin_amdgcn_mfma_f32_32x32x16_bf16(PAF(0),VFR(0),o[0],0,0,0), C0,0); \
    GAPB(o[1]=__builtin_amdgcn_mfma_f32_32x32x16_bf16(PAF(0),VFR(4),o[1],0,0,0), C0,4); \
    KRD(GL,0); GAPB(o[0]=__builtin_amdgcn_mfma_f32_32x32x16_bf16(PAF(1),VFR(1),o[0],0,0,0), C0,8); \
    KRD(GL,1); GAPB(o[1]=__builtin_amdgcn_mfma_f32_32x32x16_bf16(PAF(1),VFR(5),o[1],0,0,0), C0,12); \
    KRD(GL,2); GAPB(o[0]=__builtin_amdgcn_mfma_f32_32x32x16_bf16(PAF(2),VFR(2),o[0],0,0,0), C1,0); \
    KRD(GL,3); GAPB(o[1]=__builtin_amdgcn_mfma_f32_32x32x16_bf16(PAF(2),VFR(6),o[1],0,0,0), C1,4); \
    GAPB(o[0]=__builtin_amdgcn_mfma_f32_32x32x16_bf16(PAF(3),VFR(3),o[0],0,0,0), C1,8); \
    GAPB(o[1]=__builtin_amdgcn_mfma_f32_32x32x16_bf16(PAF(3),VFR(7),o[1],0,0,0), C1,12); \
    }while(0)
  int t=1;
  #undef CMASK
  #define CMASK(P0,P1,t) do{}while(0)
  for(;t+5<NT;t+=2){
    STEP(pB0,pB1,pA0,pA1,t,true,true,true);     WAIT_BAR(2); RESC(); ROT();
    STEP(pA0,pA1,pB0,pB1,t+1,true,true,true);   WAIT_BAR(2); RESC(); ROT();
  }
  #undef CMASK
  #define CMASK(P0,P1,t) do{}while(0)
  #define ENDW(tt) do{ if((tt)+3<NT){WAIT_BAR(2);} else if((tt)+2<NT){WAIT_BAR(1);} else {WAIT_BAR(0);} }while(0)
  for(;t+1<NT;t+=2){
    STEP(pB0,pB1,pA0,pA1,t,(t+3<NT),(t+1<NT),(t+1<NT));       ENDW(t);   RESC(); ROT();
    STEP(pA0,pA1,pB0,pB1,t+1,(t+4<NT),(t+2<NT),(t+2<NT));     ENDW(t+1); RESC(); ROT();
  }
  STEP(pB0,pB1,pA0,pA1,NT-1,false,false,false); RESC();
  { float sacc=pB0[0]+pB0[1]; _Pragma("unroll") for(int r=2;r<16;++r)sacc+=pB0[r]; _Pragma("unroll") for(int r=0;r<16;++r)sacc+=pB1[r]; l_reg+=sacc;
    pw0=(u32x4){PKW(pB0,0),PKW(pB0,2),PKW(pB0,4),PKW(pB0,6)};pw1=(u32x4){PKW(pB0,8),PKW(pB0,10),PKW(pB0,12),PKW(pB0,14)};pw2=(u32x4){PKW(pB1,0),PKW(pB1,2),PKW(pB1,4),PKW(pB1,6)};pw3=(u32x4){PKW(pB1,8),PKW(pB1,10),PKW(pB1,12),PKW(pB1,14)};
    SBAR(); pv(o,vb0+sl_cur,PAF(0),PAF(1),PAF(2),PAF(3)); }
  #undef PKW
  #undef PAF
  #undef VFR
  #undef PIN
  #undef MX3
  #undef GAPA
  #undef GAPB
  #undef EX
  #undef VRD
  #undef KRD
  #undef STEP
  #undef ENDW
  {auto rr=__builtin_amdgcn_permlane32_swap(__float_as_uint(l_reg),__float_as_uint(l_reg),false,false);l_reg=__uint_as_float(rr[0])+__uint_as_float(rr[1]);}
  if(hi==0)wsf[32+r32]=l_reg;asm volatile("s_waitcnt lgkmcnt(0)":::"memory");
  float rli[16];
  #pragma unroll
  for(int r=0;r<16;++r)rli[r]=__builtin_amdgcn_rcpf(wsf[32+crow(r,hi)]);
  bf16*Ow=O+(rowbase+q0+wid*QBLK)*QP+h*D; const bf16*Zw=Z+(rowbase+q0+wid*QBLK)*KP+h*D;
  { bf16*stg=(bf16*)(shm+LDS_OST)+wid*2048;
    #pragma unroll
    for(int r=0;r<16;++r){const int orow=crow(r,hi);
      #pragma unroll
      for(int d0=0;d0<2;++d0)stg[orow*64+d0*32+r32]=__float2bfloat16(o[d0][r]*rli[r]);}
    asm volatile("s_waitcnt lgkmcnt(0)":::"memory");
    #pragma unroll
    for(int i=0;i<4;++i){const int row=i*8+(lane>>3),ch=lane&7; const u32x4 v=*(const u32x4*)(stg+row*64+ch*8); const u32x4 zz=*(const u32x4*)(Zw+(long)row*KP+ch*8); u32x4 w;
      #pragma unroll
      for(int e=0;e<4;++e){const float a0=__uint_as_float(v[e]<<16)*__uint_as_float(zz[e]<<16),a1=__uint_as_float(v[e]&0xffff0000u)*__uint_as_float(zz[e]&0xffff0000u); w[e]=cvtpk_s(a0,a1);}
      if(wr_en)ATTN_STORE16(Ow+(long)row*QP+ch*8,w);} }
  asm volatile("s_waitcnt lgkmcnt(0)\n\ts_barrier":::"memory");
  #undef DMA_K
  #undef DMA_V
  #undef CMASK
  #undef START
  #undef RESC
  #undef ROT
}
constexpr int ATTN_LDS_BYTES=LDS_BYTES;
struct AttnTensors { const bf16* Q; const bf16* K; const bf16* V; const bf16* Z; bf16* O; };
template<int THRL=8> __device__ __forceinline__ void attn_phase(char*lds,const AttnTensors&T,int vcu,int G,bool wr_en){
  for(int U=vcu;U<BATCH*NHEAD*NQB;U+=G){ const int grp=U>>5,loc=U&31; const int b=grp&7,kvh=grp>>3,h=kvh*4+(loc>>3),qb=loc&7;
    attn_unit<THRL>(b,h,kvh,qb,T.Q,T.K,T.V,T.Z,T.O,lds,wr_en); }
}
#undef SBAR
#undef WAIT_BAR
}
constexpr int NWAVES = 8;
constexpr int BATCH = 8, SEQ = 2048, D = 1024, M = BATCH * SEQ, DEPTH = 2;
constexpr int INW = 7936, NMIX = 4864, NGATE = 3072, QUP = 1536, RESTP = 3328;
constexpr float LN_EPS = 1e-5f;
using pg8::LOG2E; using pg8::C2;
constexpr float ALPHA = 1.4142135623730951f;
constexpr size_t MiB = 1u << 20;
constexpr size_t WS_BIASV = 0;
constexpr size_t WS_WIN = 1 * MiB;
constexpr size_t WS_WBR = 32 * MiB;
constexpr size_t WS_WOUT = 38 * MiB;
constexpr size_t WS_SGW = 42 * MiB;
constexpr size_t WS_XN = 44 * MiB;
constexpr size_t WS_QU = 76 * MiB;
constexpr size_t WS_REST = 124 * MiB;
constexpr size_t WS_END = 229 * MiB;
constexpr int RING_OFF = 0;
constexpr int LDS_BYTES = 163840;
constexpr int MISC_OFF = LDS_BYTES - 64;
constexpr size_t WS_BAR = 228 * MiB;

#define GAS __attribute__((address_space(1)))
#define LAS __attribute__((address_space(3)))
typedef unsigned short bf16;
typedef unsigned v4u __attribute__((ext_vector_type(4)));
typedef unsigned v2u __attribute__((ext_vector_type(2)));
typedef float f32x4 __attribute__((ext_vector_type(4)));
typedef short bf16x8 __attribute__((ext_vector_type(8)));
#define LDS_WAIT() asm volatile("s_waitcnt lgkmcnt(0)" ::: "memory")
__device__ __forceinline__ unsigned f2bf(float f) { unsigned u = __builtin_bit_cast(unsigned, f); return (u + 0x7fffu + ((u >> 16) & 1u)) >> 16; }
__device__ __forceinline__ unsigned pk2(float lo, float hi) { return f2bf(lo) | (f2bf(hi) << 16); }
__device__ __forceinline__ float bflo(unsigned w) { return __uint_as_float(w << 16); }
__device__ __forceinline__ float bfhi(unsigned w) { return __uint_as_float(w & 0xffff0000u); }
__device__ __forceinline__ float wave_sum(float v) {
#pragma unroll
    for (int o = 1; o < 64; o <<= 1) v += __shfl_xor(v, o);
    return v;
}
__host__ __device__ __forceinline__ int v2l(int vc) {
    if (vc < 512) return vc;
    if (vc < 1024) return vc - 512 + 2048;
    if (vc < 1536) return vc - 1024 + 3328;
    if (vc < 2048) return vc - 1536 + 512;
    if (vc < 2560) return vc - 2048 + 1024;
    if (vc < 3072) return vc - 2560 + 1536;
    if (vc < 3200) return vc - 3072 + 2560;
    if (vc < 3328) return vc - 3200 + 2688;
    if (vc < 3840) return vc - 3328 + 2816;
    return vc;
}
__device__ __forceinline__ void transpose_item(const float* W, int N, int k0, int n0, bf16* WT, int ldt, int dst_row0, int kofs, LAS float* scr, int lane) {
    float tv[32];
#pragma unroll
    for (int i = 0; i < 32; ++i) tv[i] = __builtin_nontemporal_load(W + (size_t)(k0 + 2 * i + (lane >> 5)) * N + n0 + (lane & 31));
#pragma unroll
    for (int i = 0; i < 32; ++i) scr[(2 * i + (lane >> 5)) * 33 + (lane & 31)] = tv[i];
    LDS_WAIT(); asm volatile("" ::: "memory");
    const int c = lane & 7;
#pragma unroll
    for (int j = 0; j < 4; ++j) { const int n = (lane >> 3) + 8 * j; const LAS float* s = scr + (8 * c) * 33 + n;
        v4u o; o.x = pk2(s[0 * 33], s[1 * 33]); o.y = pk2(s[2 * 33], s[3 * 33]); o.z = pk2(s[4 * 33], s[5 * 33]); o.w = pk2(s[6 * 33], s[7 * 33]);
        *(GAS v4u*)(WT + (size_t)(dst_row0 + n) * ldt + kofs + k0 + 8 * c) = o; }
    LDS_WAIT(); asm volatile("" ::: "memory");
}
template <int NR> __device__ __forceinline__ void ln_rows(const float* xbase, int m0, int stride, int mmax, const float* g, const float* bta, float* obase, bf16* bbase, int lane, bool wr_en = true) {
    f32x4 v[NR][4]; float s[NR];
#pragma unroll
    for (int r = 0; r < NR; ++r) { const int m = min(m0 + r * stride, mmax - 1); const GAS f32x4* xr = (const GAS f32x4*)(xbase + (size_t)m * D) + lane; s[r] = 0.f;
#pragma unroll
        for (int j = 0; j < 4; ++j) v[r][j] = xr[64 * j]; }
#pragma unroll
    for (int r = 0; r < NR; ++r)
#pragma unroll
        for (int j = 0; j < 4; ++j) s[r] += (v[r][j].x + v[r][j].y) + (v[r][j].z + v[r][j].w);
#pragma unroll
    for (int o = 1; o < 64; o <<= 1)
#pragma unroll
        for (int r = 0; r < NR; ++r) s[r] += __shfl_xor(s[r], o);
    float s2[NR];
#pragma unroll
    for (int r = 0; r < NR; ++r) { const float mean = s[r] * (1.f / D); s2[r] = 0.f;
#pragma unroll
        for (int j = 0; j < 4; ++j) { v[r][j] = v[r][j] - mean; s2[r] += (v[r][j].x * v[r][j].x + v[r][j].y * v[r][j].y) + (v[r][j].z * v[r][j].z + v[r][j].w * v[r][j].w); } }
#pragma unroll
    for (int o = 1; o < 64; o <<= 1)
#pragma unroll
        for (int r = 0; r < NR; ++r) s2[r] += __shfl_xor(s2[r], o);
#pragma unroll
    for (int j = 0; j < 4; ++j) { const f32x4 gg = ((const GAS f32x4*)g)[lane + 64 * j], bb = ((const GAS f32x4*)bta)[lane + 64 * j];
#pragma unroll
        for (int r = 0; r < NR; ++r) { const int m = m0 + r * stride; const float rstd = 1.f / sqrtf(s2[r] * (1.f / D) + LN_EPS); const f32x4 y = v[r][j] * rstd * gg + bb;
            if (wr_en && m < mmax) { ((GAS f32x4*)(obase + (size_t)m * D) + lane)[64 * j] = y; v2u w; w.x = pk2(y.x, y.y); w.y = pk2(y.z, y.w); ((GAS v2u*)(bbase + (size_t)m * D) + lane)[64 * j] = w; } } }
}

#define RLX_AGENT __ATOMIC_RELAXED, __HIP_MEMORY_SCOPE_AGENT
#define XB_TMO      128
#define XB_XCNT(j)  (256  + 64 * (j))
#define XB_XSUB(j)  (1280 + 64 * (j))
#define XB_XGEN(j)  (2304 + 64 * (j))
#define XB_TOP      3328
#define XB_TOPGEN   3392
#define XCD_BAR_WORDS 3456
#define XB_SPIN_CAP (1u << 18)

__device__ __forceinline__ unsigned xb_ld(unsigned* p)              { return __hip_atomic_load(p, __ATOMIC_RELAXED, __HIP_MEMORY_SCOPE_AGENT); }
__device__ __forceinline__ unsigned xb_add(unsigned* p, unsigned v) { return __hip_atomic_fetch_add(p, v, __ATOMIC_RELAXED, __HIP_MEMORY_SCOPE_AGENT); }
__device__ __forceinline__ unsigned xb_xcc_id() { return (unsigned)__builtin_amdgcn_s_getreg((3 << 11) | 20) & 0xFu; }
#define XB_SPIN(cond, bar) do { unsigned _sp = 0; while (cond) { __builtin_amdgcn_s_sleep(1); \
    if ((++_sp & 255u) == 0u) { if (xb_ld(&(bar)[XB_TMO])) break; if (_sp > XB_SPIN_CAP) { atomicAdd(&(bar)[XB_TMO], 1u); break; } } } } while (0)

struct XcdBarrier {
    unsigned* bar; unsigned x;
    volatile LAS unsigned* st;
};

__device__ __forceinline__ XcdBarrier xcd_barrier_post(unsigned* bar, volatile LAS unsigned* st) {
    XcdBarrier b; b.bar = bar; b.x = xb_xcc_id(); b.st = st;
    if (threadIdx.x == 0) (void)xb_add(&bar[XB_XCNT(b.x)], 1u);
    return b;
}
__device__ __forceinline__ void xcd_barrier_complete(unsigned* bar, unsigned x, unsigned& nloc, unsigned& nx) {
    const unsigned G = gridDim.x * gridDim.y * gridDim.z;
    unsigned sum, cnt, mine, sp = 0u;
    for (;;) {
        sum = 0u; cnt = 0u; mine = 0u;
#pragma unroll
        for (unsigned j = 0; j < 16; ++j) { const unsigned c = xb_ld(&bar[XB_XCNT(j)]); sum += c; cnt += (c > 0u) ? 1u : 0u; mine = (j == x) ? c : mine; }
        if (sum == G) break;
        __builtin_amdgcn_s_sleep(1);
        if ((++sp & 255u) == 0u) { if (xb_ld(&bar[XB_TMO])) break; if (sp > XB_SPIN_CAP) { atomicAdd(&bar[XB_TMO], 1u); break; } }
    }
    nloc = mine > 0u ? mine : 1u; nx = cnt > 0u ? cnt : 1u;
}

__device__ __forceinline__ void xcd_barrier(const XcdBarrier& b) {
    asm volatile("s_waitcnt vmcnt(0)" ::: "memory");
    __syncthreads();
    if (threadIdx.x == 0) {
        unsigned* bar = b.bar;
        __builtin_amdgcn_s_waitcnt(0);
        unsigned nloc = b.st[0], nx = b.st[1];
        if (nloc == 0u) { xcd_barrier_complete(bar, b.x, nloc, nx); b.st[0] = nloc; b.st[1] = nx; }
        const unsigned old = xb_add(&bar[XB_XSUB(b.x)], 1u);
        const unsigned gen = old / nloc;
        if (old + 1u == (gen + 1u) * nloc) {
            __builtin_amdgcn_fence(__ATOMIC_RELEASE, "agent");
            asm volatile("s_waitcnt vmcnt(0)" ::: "memory");
            const unsigned og = xb_add(&bar[XB_TOP], 1u);
            const unsigned tg = og / nx;
            if (og + 1u == (tg + 1u) * nx) xb_add(&bar[XB_TOPGEN], 1u);
            else XB_SPIN(xb_ld(&bar[XB_TOPGEN]) == tg, bar);
            __builtin_amdgcn_fence(__ATOMIC_ACQUIRE, "agent");
            xb_add(&bar[XB_XGEN(b.x)], 1u);
            asm volatile("s_waitcnt vmcnt(0)" ::: "memory");
        } else {
            XB_SPIN(xb_ld(&bar[XB_XGEN(b.x)]) == gen, bar);
            __builtin_amdgcn_fence(__ATOMIC_ACQUIRE, "agent");
            asm volatile("s_waitcnt vmcnt(0)" ::: "memory");
        }
    }
    __syncthreads();
}

constexpr int NA_K = 0, NA_V = 65536, NA_MS = 131072, NA_ML = NA_MS + 4 * 16 * 68 * 4, NA_RP = NA_ML + 8 * 32 * 4, NA_END = NA_RP + 480 * 4;
static_assert(NA_END <= LDS_BYTES, "NA LDS map");
__device__ __forceinline__ void na_stage_write(LAS unsigned char* lds, int slot, int key, int dc, v4u kv, v4u vv) {
    *(LAS v4u*)(lds + NA_K + slot * 8192 + key * 128 + ((dc ^ (key & 7)) << 4)) = kv;
    LAS unsigned char* vb = lds + NA_V + slot * 8192 + (dc * 8) * 128 + (key & 7) * 2; const int kc = key >> 3;
#pragma unroll
    for (int e = 0; e < 4; ++e) {
        *(LAS unsigned short*)(vb + (2 * e) * 128 + ((kc ^ (2 * e)) << 4)) = (unsigned short)(vv[e] & 0xffffu);
        *(LAS unsigned short*)(vb + (2 * e + 1) * 128 + ((kc ^ (2 * e + 1)) << 4)) = (unsigned short)(vv[e] >> 16); }
}
__device__ __forceinline__ void na_unit(LAS unsigned char* lds, int b, int h, int oct, bf16* QU, const bf16* REST, const float* rpb, bool wr_en) {
    int tid_ = threadIdx.x; asm volatile("" : "+v"(tid_)); const int tid = tid_, lane = tid & 63, wid = __builtin_amdgcn_readfirstlane(tid >> 6), fr = lane & 15, fq = lane >> 4;
    const int qb = wid & 3, kh = wid >> 2, c0 = 16 * qb, w0 = min(max(16 * qb - 8, 0), 32);
    bf16* Qb = QU + (size_t)b * SEQ * QUP + h * 64;
    const bf16* Kb = REST + (size_t)b * SEQ * RESTP + h * 64; const bf16* Vb = Kb + 512; const bf16* Zb = Kb + 1024;
    LAS float* RP = (LAS float*)(lds + NA_RP); LAS float* ML = (LAS float*)(lds + NA_ML); LAS float* MS = (LAS float*)(lds + NA_MS);
    if (tid < 465) RP[tid] = rpb[h * 465 + tid] * LOG2E;
    const int skey = tid >> 3, sdc = tid & 7;
    int rs = min(max(8 * oct - 4, 0), 24);
#pragma unroll
    for (int half = 0; half < 2; ++half) { v4u kv[4], vv[4];
#pragma unroll
        for (int j = 0; j < 4; ++j) { const int kr = rs + half * 4 + j; const size_t off = (size_t)(kr * 64 + skey) * RESTP + sdc * 8; kv[j] = *(const v4u*)(Kb + off); vv[j] = *(const v4u*)(Vb + off); }
#pragma unroll
        for (int j = 0; j < 4; ++j) { const int kr = rs + half * 4 + j; na_stage_write(lds, kr & 7, skey, sdc, kv[j], vv[j]); } }
    __syncthreads();
    for (int i = 0; i < 8; ++i) {
        const int r = 8 * oct + i;
        const int rs_next = (i < 7) ? min(max(r + 1 - 4, 0), 24) : rs; const bool adv = rs_next > rs;
        v4u pk = (v4u){0u, 0u, 0u, 0u}, pv = pk;
        if (adv) { const size_t off = (size_t)((rs_next + 7) * 64 + skey) * RESTP + sdc * 8; pk = *(const v4u*)(Kb + off); pv = *(const v4u*)(Vb + off); }
        const bf16* qp = Qb + (size_t)(r * 64 + c0 + fr) * QUP + fq * 8;
        const bf16x8 q0 = *(const bf16x8*)qp, q1 = *(const bf16x8*)(qp + 32);
        const int c = c0 + fr, cs = min(max(c - 8, 0), 48);
        float sc[4][8]; float mx = -1e30f;
        const int keya = w0 + 8 * (fr >> 2) + (fr & 3);
#pragma unroll
        for (int jr = 0; jr < 4; ++jr) { const int kr = rs + kh * 4 + jr, slot = kr & 7;
            const LAS unsigned char* kb = lds + NA_K + slot * 8192;
            const int ka = keya, kbk = keya + 4;
            const bf16x8 a0 = *(const LAS bf16x8*)(kb + ka * 128 + ((fq ^ (ka & 7)) << 4)), a1 = *(const LAS bf16x8*)(kb + ka * 128 + (((4 + fq) ^ (ka & 7)) << 4));
            const bf16x8 b0 = *(const LAS bf16x8*)(kb + kbk * 128 + ((fq ^ (kbk & 7)) << 4)), b1 = *(const LAS bf16x8*)(kb + kbk * 128 + (((4 + fq) ^ (kbk & 7)) << 4));
            f32x4 sa = (f32x4){0.f, 0.f, 0.f, 0.f}, sb = sa;
            sa = __builtin_amdgcn_mfma_f32_16x16x32_bf16(a0, q0, sa, 0, 0, 0); sa = __builtin_amdgcn_mfma_f32_16x16x32_bf16(a1, q1, sa, 0, 0, 0);
            sb = __builtin_amdgcn_mfma_f32_16x16x32_bf16(b0, q0, sb, 0, 0, 0); sb = __builtin_amdgcn_mfma_f32_16x16x32_bf16(b1, q1, sb, 0, 0, 0);
            const LAS float* rprow = RP + (kr - r + 7) * 31 + 15 - c;
#pragma unroll
            for (int jj = 0; jj < 8; ++jj) { const int k = w0 + 8 * fq + jj; const bool ok = (k >= cs) && (k < cs + 16);
                const float s = (jj < 4 ? sa[jj] : sb[jj - 4]) + (ok ? rprow[k] : 0.f);
                sc[jr][jj] = ok ? s : -1e30f; mx = fmaxf(mx, sc[jr][jj]); } }
        mx = fmaxf(mx, __shfl_xor(mx, 16)); mx = fmaxf(mx, __shfl_xor(mx, 32));
        float ls = 0.f; bf16x8 pa[4];
#pragma unroll
        for (int jr = 0; jr < 4; ++jr) { float p[8];
#pragma unroll
            for (int jj = 0; jj < 8; ++jj) { p[jj] = __builtin_amdgcn_exp2f(sc[jr][jj] - mx); ls += p[jj]; }
            v4u w; w.x = pk2(p[0], p[1]); w.y = pk2(p[2], p[3]); w.z = pk2(p[4], p[5]); w.w = pk2(p[6], p[7]); pa[jr] = __builtin_bit_cast(bf16x8, w); }
        ls += __shfl_xor(ls, 16); ls += __shfl_xor(ls, 32);
        f32x4 o[4];
#pragma unroll
        for (int db = 0; db < 4; ++db) { o[db] = (f32x4){0.f, 0.f, 0.f, 0.f}; const int d = 16 * db + fr;
#pragma unroll
            for (int jr = 0; jr < 4; ++jr) { const int slot = (rs + kh * 4 + jr) & 7;
                const bf16x8 vb = *(const LAS bf16x8*)(lds + NA_V + slot * 8192 + d * 128 + ((((w0 >> 3) + fq) ^ (d & 7)) << 4));
                o[db] = __builtin_amdgcn_mfma_f32_16x16x32_bf16(pa[jr], vb, o[db], 0, 0, 0); } }
        if (fq == 0) { ML[wid * 32 + fr] = mx; ML[wid * 32 + 16 + fr] = ls; }
        if (kh == 1) {
#pragma unroll
            for (int db = 0; db < 4; ++db)
#pragma unroll
                for (int j = 0; j < 4; ++j) MS[(qb * 16 + 4 * fq + j) * 68 + 16 * db + fr] = o[db][j]; }
        __syncthreads();
        if (adv) na_stage_write(lds, (rs_next + 7) & 7, skey, sdc, pk, pv);
        if (kh == 0) {
#pragma unroll
            for (int j = 0; j < 4; ++j) { const int q = 4 * fq + j;
                const float m0 = ML[wid * 32 + q], l0 = ML[wid * 32 + 16 + q], m1 = ML[(wid + 4) * 32 + q], l1 = ML[(wid + 4) * 32 + 16 + q];
                const float mt = fmaxf(m0, m1), a0 = __builtin_amdgcn_exp2f(m0 - mt), a1 = __builtin_amdgcn_exp2f(m1 - mt), inv = 1.0f / (l0 * a0 + l1 * a1);
                const size_t tok = (size_t)(r * 64 + c0 + q);
#pragma unroll
                for (int db = 0; db < 4; ++db) { const int d = 16 * db + fr;
                    const float ov = (o[db][j] * a0 + MS[(qb * 16 + q) * 68 + d] * a1) * inv;
                    const float z = __uint_as_float((unsigned)Zb[tok * RESTP + d] << 16);
                    if (wr_en) Qb[tok * QUP + d] = (bf16)f2bf(ov * z); } } }
        __syncthreads();
        rs = rs_next;
    }
}

__device__ __forceinline__ void sg_unit(LAS unsigned char* lds, int b, int chunk, int gh, bf16* QU, const bf16* REST, const float* lng, const float* lnb, const bf16* sgw, const float* sgb, bool wr_en) {
    int tid_ = threadIdx.x; asm volatile("" : "+v"(tid_)); const int tid = tid_, lane = tid & 63, wid = __builtin_amdgcn_readfirstlane(tid >> 6), fr = lane & 15, fq = lane >> 4;
    const size_t tok0 = (size_t)b * SEQ + chunk * 128;
    const bf16* Vp = REST + tok0 * RESTP + 2304; const bf16* Zp = REST + tok0 * RESTP + 2816; bf16* Up = QU + tok0 * QUP + 1024;
    {
        f32x4 g0 = *(const f32x4*)(lng + lane * 8), g1 = *(const f32x4*)(lng + lane * 8 + 4), b0 = *(const f32x4*)(lnb + lane * 8), b1 = *(const f32x4*)(lnb + lane * 8 + 4);
        const bool mine = (lane >> 5) == gh; const int cl0 = (lane & 31) * 8;
        for (int i = 0; i < 16; ++i) { const int n = wid * 16 + i;
            const v4u raw = *(const v4u*)(Vp + (size_t)n * RESTP + lane * 8);
            float x[8];
#pragma unroll
            for (int e = 0; e < 4; ++e) { x[2 * e] = bflo(raw[e]); x[2 * e + 1] = bfhi(raw[e]); }
            float s = 0.f;
#pragma unroll
            for (int e = 0; e < 8; ++e) s += x[e];
            const float mean = wave_sum(s) * (1.0f / 512.0f); float s2 = 0.f;
#pragma unroll
            for (int e = 0; e < 8; ++e) { x[e] -= mean; s2 += x[e] * x[e]; }
            const float rstd = 1.f / sqrtf(wave_sum(s2) * (1.0f / 512.0f) + LN_EPS);
            if (mine) {
#pragma unroll
                for (int e = 0; e < 8; ++e) { const float y = x[e] * rstd * (e < 4 ? g0[e] : g1[e - 4]) + (e < 4 ? b0[e] : b1[e - 4]); const int cl = cl0 + e;
                    *(LAS unsigned short*)(lds + cl * 256 + (((n >> 3) ^ (cl & 15)) << 4) + (n & 7) * 2) = (unsigned short)f2bf(y); } }
        }
    }
    __syncthreads();
    {
        const int gl = wid & 3, g = 4 * gh + gl, mh = wid >> 2;
        const bf16* Wg = sgw + (size_t)g * 128 * 128;
        f32x4 acc[4][4];
#pragma unroll
        for (int db = 0; db < 4; ++db)
#pragma unroll
            for (int mb = 0; mb < 4; ++mb) acc[db][mb] = (f32x4){0.f, 0.f, 0.f, 0.f};
#pragma unroll
        for (int ks = 0; ks < 4; ++ks) { bf16x8 af[4], bfr[4];
#pragma unroll
            for (int db = 0; db < 4; ++db) { const int cl = gl * 64 + 16 * db + fr; af[db] = *(const LAS bf16x8*)(lds + cl * 256 + (((ks * 4 + fq) ^ (cl & 15)) << 4)); }
#pragma unroll
            for (int mb = 0; mb < 4; ++mb) bfr[mb] = *(const bf16x8*)(Wg + (size_t)(64 * mh + 16 * mb + fr) * 128 + ks * 32 + fq * 8);
#pragma unroll
            for (int db = 0; db < 4; ++db)
#pragma unroll
                for (int mb = 0; mb < 4; ++mb) acc[db][mb] = __builtin_amdgcn_mfma_f32_16x16x32_bf16(af[db], bfr[mb], acc[db][mb], 0, 0, 0); }
#pragma unroll
        for (int mb = 0; mb < 4; ++mb) { const int m = 64 * mh + 16 * mb + fr; const float bs = sgb[g * 128 + m];
#pragma unroll
            for (int db = 0; db < 4; ++db) { const int c = 64 * g + 16 * db + 4 * fq;
                const v2u uu = *(const v2u*)(Up + (size_t)m * QUP + c), zz = *(const v2u*)(Zp + (size_t)m * RESTP + c); const f32x4 a = acc[db][mb];
                v2u w; w.x = pk2(bflo(uu.x) * (a[0] + bs) * bflo(zz.x), bfhi(uu.x) * (a[1] + bs) * bfhi(zz.x)); w.y = pk2(bflo(uu.y) * (a[2] + bs) * bflo(zz.y), bfhi(uu.y) * (a[3] + bs) * bfhi(zz.y));
                if (wr_en) *(v2u*)(Up + (size_t)m * QUP + c) = w; } }
    }
    __syncthreads();
}
struct Args {
    const float *x, *ln_in_g, *ln_in_b, *w_in, *b_in, *na_rpb, *q_norm_g, *k_norm_g, *sg_ln_g, *sg_ln_b, *sg_w, *sg_b, *w_br_a, *w_br_b, *w_br_c, *w_out, *b_out, *ln_post_g, *ln_post_b;
    float* out; unsigned char* ws; int force; int pad;
};
#ifndef PROBE
#define PROBE 0
#endif
typedef const __attribute__((address_space(4))) Args* KArgs;
__device__ __forceinline__ KArgs kargs() { KArgs p = (KArgs)__builtin_amdgcn_kernarg_segment_ptr(); asm volatile("" : "+s"(p)); return p; }
#define WSP(off) ((unsigned char*)kargs()->ws + (off))
__global__ void __launch_bounds__(NWAVES * 64, 2) mega_fwd(Args a_unused) {
    extern __shared__ __attribute__((aligned(16))) unsigned char lds_raw[];
    cg::grid_group grid = cg::this_grid();
    LAS unsigned char* lds = (LAS unsigned char*)lds_raw;
    const int tid = threadIdx.x, lane = tid & 63, wave = __builtin_amdgcn_readfirstlane(tid >> 6);
    const int G = gridDim.x, bx = blockIdx.x; const int vcu = (G % 8 == 0) ? (bx % 8) * (G / 8) + bx / 8 : bx;
    if (tid < 16) ((LAS unsigned*)(lds + MISC_OFF))[tid] = 0u;
    if (bx == 0) { unsigned* barw = (unsigned*)WSP(WS_BAR); for (int i = tid; i < XCD_BAR_WORDS; i += NWAVES * 64) barw[i] = 0u; }
    __syncthreads();
    const int gw = vcu * NWAVES + wave, NGW = G * NWAVES;
#define BIASV ((float*)WSP(WS_BIASV))
#define WIN ((bf16*)WSP(WS_WIN))
#define WBR ((bf16*)WSP(WS_WBR))
#define WOUT ((bf16*)WSP(WS_WOUT))
#define SGW ((bf16*)WSP(WS_SGW))
#define XN ((bf16*)WSP(WS_XN))
#define QU ((bf16*)WSP(WS_QU))
#define REST ((bf16*)WSP(WS_REST))
#define GT REST
#define H (kargs()->out)

#define GRID_BAR() do { XcdBarrier b_; b_.bar = (unsigned*)WSP(WS_BAR); b_.x = xb_xcc_id(); b_.st = (volatile LAS unsigned*)(lds + MISC_OFF); xcd_barrier(b_); } while (0)
#ifndef SKIPMASK
#define SKIPMASK 0
#endif
#define SKIP(b) (SKIPMASK != 0 && pass == 0 && ((SKIPMASK) & (b)))
    { constexpr int pass = 0;
    if (!SKIP(1)) for (int rep = 0; rep < ((PROBE & 64) ? 2 : 1); ++rep) {
        LAS float* scr = (LAS float*)(lds + wave * 16384);
        constexpr int I_IN = 16 * (INW / 32), I_BR = 8 * 32, I_OUT = 16 * 32;
        constexpr int PER_L = I_IN + 3 * I_BR + I_OUT, NITEMS = DEPTH * PER_L;
        for (int it = gw; it < NITEMS; it += NGW) {
            const int l = it / PER_L; int r = it % PER_L;
            if (r < I_IN) { const int kb = r / (INW / 32), pb = r % (INW / 32);
                const int tile = pb >> 3, wblk = pb & 7, bj = wblk >> 2, wc = wblk & 3; const int vc0 = tile * 256 + wc * 64 + bj * 32;
                transpose_item(kargs()->w_in + (size_t)l * D * INW, INW, 64 * kb, v2l(vc0), WIN + (size_t)l * INW * D, D, 32 * pb, 0, scr, lane); continue; }
            r -= I_IN;
            if (r < 3 * I_BR) { const int br = r / I_BR, q = r % I_BR, kb = q / 32, nb = q % 32; const float* W = (br == 0 ? kargs()->w_br_a : br == 1 ? kargs()->w_br_b : kargs()->w_br_c) + (size_t)l * 512 * D;
                transpose_item(W, D, 64 * kb, 32 * nb, WBR + (size_t)l * D * 1536, 1536, 32 * nb, 512 * br, scr, lane); continue; }
            r -= 3 * I_BR;
            { const int kb = r / 32, nb = r % 32; transpose_item(kargs()->w_out + (size_t)l * D * D, D, 64 * kb, 32 * nb, WOUT + (size_t)l * D * D, D, 32 * nb, 0, scr, lane); }
        }
        const int gt = (vcu * NWAVES + wave) * 64 + lane, NGT = NGW * 64;
        for (int i = gt; i < DEPTH * 8 * 128 * 128 / 2; i += NGT) { const float2 v = ((const float2*)kargs()->sg_w)[i]; ((unsigned*)SGW)[i] = pk2(v.x, v.y); }
        for (int i = gt; i < DEPTH * INW; i += NGT) { const int l = i / INW, p = i % INW; BIASV[i] = kargs()->b_in[l * INW + v2l(p)]; }
        for (int m = gw; m < M; m += 4 * NGW) ln_rows<4>(kargs()->x, m, NGW, M, kargs()->ln_in_g, kargs()->ln_in_b, H, XN, lane);
    }
    if (pass > 0) GRID_BAR();
    if (pass == 0) {
    grid.sync();
    (void)xcd_barrier_post((unsigned*)WSP(WS_BAR), (volatile LAS unsigned*)(lds + MISC_OFF));
    }

    { constexpr int l = 0;
#ifndef NO_P1
        if (!SKIP(2)) for (int rep = 0; rep < ((PROBE & 16) ? 2 : 1); ++rep) {
            pg8::Gemm g{XN, WIN + (size_t)l * INW * D, M, NMIX, D, D, D}; pg8::StaticOrder S; S.init(M, NMIX, G, bx);
            pg8::EpiIn E{QU, REST, BIASV + l * INW, kargs()->q_norm_g + l * 64, kargs()->k_norm_g + l * 64};
            pg8::gemm_phase<pg8::EpiIn, pg8::StaticOrder, true, true>(lds + RING_OFF, g, S, E);
        }
#endif
        GRID_BAR();
        {
            const attn_body::AttnTensors AT{(const attn_body::bf16*)(QU + 512), (const attn_body::bf16*)(REST + 1536), (const attn_body::bf16*)(REST + 1664), (const attn_body::bf16*)(REST + 1792), (attn_body::bf16*)(QU + 512)};
#ifndef NO_ATT
            if (!SKIP(4)) for (int rep = 0; rep < ((PROBE & 8) ? 2 : 1); ++rep) { attn_body::attn_phase<8>((char*)lds_raw + RING_OFF, AT, vcu, G, (rep == ((PROBE & 8) ? 1 : 0)) || (kargs()->force != 0)); __syncthreads(); }
#endif
            __syncthreads();
#ifndef NO_NA
            if (!SKIP(8)) for (int rep = 0; rep < ((PROBE & 2) ? 2 : 1); ++rep)
            for (int U = vcu; U < BATCH * 8 * 4; U += G) na_unit(lds, U >> 5, (U >> 2) & 7, U & 3, QU, REST, kargs()->na_rpb + (size_t)l * 8 * 465, (rep == ((PROBE & 2) ? 1 : 0)) || (kargs()->force != 0));
#endif
            __syncthreads();
#ifndef NO_SG
            if (!SKIP(16)) for (int rep = 0; rep < ((PROBE & 4) ? 2 : 1); ++rep)
            for (int U = vcu; U < BATCH * 16 * 2; U += G) sg_unit(lds, U >> 5, (U >> 1) & 15, U & 1, QU, REST, kargs()->sg_ln_g + l * 512, kargs()->sg_ln_b + l * 512, SGW + (size_t)l * 8 * 128 * 128, kargs()->sg_b + l * 8 * 128, (rep == ((PROBE & 4) ? 1 : 0)) || (kargs()->force != 0));
#endif
        }
        GRID_BAR();
#ifndef NO_P1B
        if (!SKIP(32)) for (int rep = 0; rep < ((PROBE & 32) ? 2 : 1); ++rep) {
            pg8::Gemm g{XN, WIN + (size_t)l * INW * D + (size_t)NMIX * D, M, NGATE, D, D, D}; pg8::StaticOrder S; S.init(M, NGATE, G, bx);
            pg8::EpiGate E{GT, BIASV + l * INW + NMIX};
            pg8::gemm_phase<pg8::EpiGate, pg8::StaticOrder, true, true>(lds + RING_OFF, g, S, E);
        }
#endif
        GRID_BAR();
#ifndef NO_P3
        if (!SKIP(64)) for (int rep = 0; rep < ((PROBE & 32) ? 2 : 1); ++rep) {
            pg8::Gemm g{QU, WBR + (size_t)l * D * 1536, M, D, 1536, 1536, 1536}; pg8::StaticOrder S; S.init(M, D, G, bx);
            pg8::EpiMerge E{GT, XN};
            pg8::gemm_phase<pg8::EpiMerge, pg8::StaticOrder, true, true>(lds + RING_OFF, g, S, E);
        }
#endif
        GRID_BAR();
#ifndef NO_P4
        if (!SKIP(128)) for (int rep = 0; rep < ((PROBE & 128) ? 2 : 1); ++rep) {
            pg8::Gemm g{XN, WOUT + (size_t)l * D * D, M, D, D, D, D}; pg8::StaticOrder S; S.init(M, D, G, bx);
            pg8::EpiOut E{H, kargs()->b_out + l * D, ALPHA, (rep == ((PROBE & 128) ? 1 : 0)) || (kargs()->force != 0)};
            pg8::gemm_phase<pg8::EpiOut, pg8::StaticOrder, true, true>(lds + RING_OFF, g, S, E);
        }
#endif
        GRID_BAR();
        if (!SKIP(256)) for (int rep = 0; rep < ((PROBE & 256) ? 2 : 1); ++rep)
        for (int m = gw; m < M; m += 4 * NGW) ln_rows<4>(H, m, NGW, M, kargs()->ln_post_g + l * D, kargs()->ln_post_b + l * D, H, XN, lane, (rep == ((PROBE & 256) ? 1 : 0)) || (kargs()->force != 0));
        if (l + 1 < DEPTH) GRID_BAR();
        if (PROBE & 1) { for (int i = 0; i < 6; ++i) GRID_BAR(); }
    }
    { constexpr int l = 1;
#ifndef NO_P1
        if (!SKIP(2)) for (int rep = 0; rep < ((PROBE & 16) ? 2 : 1); ++rep) {
            pg8::Gemm g{XN, WIN + (size_t)l * INW * D, M, NMIX, D, D, D}; pg8::StaticOrder S; S.init(M, NMIX, G, bx);
            pg8::EpiIn E{QU, REST, BIASV + l * INW, kargs()->q_norm_g + l * 64, kargs()->k_norm_g + l * 64};
            pg8::gemm_phase<pg8::EpiIn, pg8::StaticOrder, true, true>(lds + RING_OFF, g, S, E);
        }
#endif
        GRID_BAR();
        {
            const attn_body::AttnTensors AT{(const attn_body::bf16*)(QU + 512), (const attn_body::bf16*)(REST + 1536), (const attn_body::bf16*)(REST + 1664), (const attn_body::bf16*)(REST + 1792), (attn_body::bf16*)(QU + 512)};
#ifndef NO_ATT
            if (!SKIP(4)) for (int rep = 0; rep < ((PROBE & 8) ? 2 : 1); ++rep) { attn_body::attn_phase<8>((char*)lds_raw + RING_OFF, AT, vcu, G, (rep == ((PROBE & 8) ? 1 : 0)) || (kargs()->force != 0)); __syncthreads(); }
#endif
            __syncthreads();
#ifndef NO_NA
            if (!SKIP(8)) for (int rep = 0; rep < ((PROBE & 2) ? 2 : 1); ++rep)
            for (int U = vcu; U < BATCH * 8 * 4; U += G) na_unit(lds, U >> 5, (U >> 2) & 7, U & 3, QU, REST, kargs()->na_rpb + (size_t)l * 8 * 465, (rep == ((PROBE & 2) ? 1 : 0)) || (kargs()->force != 0));
#endif
            __syncthreads();
#ifndef NO_SG
            if (!SKIP(16)) for (int rep = 0; rep < ((PROBE & 4) ? 2 : 1); ++rep)
            for (int U = vcu; U < BATCH * 16 * 2; U += G) sg_unit(lds, U >> 5, (U >> 1) & 15, U & 1, QU, REST, kargs()->sg_ln_g + l * 512, kargs()->sg_ln_b + l * 512, SGW + (size_t)l * 8 * 128 * 128, kargs()->sg_b + l * 8 * 128, (rep == ((PROBE & 4) ? 1 : 0)) || (kargs()->force != 0));
#endif
        }
        GRID_BAR();
#ifndef NO_P1B
        if (!SKIP(32)) for (int rep = 0; rep < ((PROBE & 32) ? 2 : 1); ++rep) {
            pg8::Gemm g{XN, WIN + (size_t)l * INW * D + (size_t)NMIX * D, M, NGATE, D, D, D}; pg8::StaticOrder S; S.init(M, NGATE, G, bx);
            pg8::EpiGate E{GT, BIASV + l * INW + NMIX};
            pg8::gemm_phase<pg8::EpiGate, pg8::StaticOrder, true, true>(lds + RING_OFF, g, S, E);
        }
#endif
        GRID_BAR();
#ifndef NO_P3
        if (!SKIP(64)) for (int rep = 0; rep < ((PROBE & 32) ? 2 : 1); ++rep) {
            pg8::Gemm g{QU, WBR + (size_t)l * D * 1536, M, D, 1536, 1536, 1536}; pg8::StaticOrder S; S.init(M, D, G, bx);
            pg8::EpiMerge E{GT, XN};
            pg8::gemm_phase<pg8::EpiMerge, pg8::StaticOrder, true, true>(lds + RING_OFF, g, S, E);
        }
#endif
        GRID_BAR();
#ifndef NO_P4
        if (!SKIP(128)) for (int rep = 0; rep < ((PROBE & 128) ? 2 : 1); ++rep) {
            pg8::Gemm g{XN, WOUT + (size_t)l * D * D, M, D, D, D, D}; pg8::StaticOrder S; S.init(M, D, G, bx);
            pg8::EpiOut E{H, kargs()->b_out + l * D, ALPHA, (rep == ((PROBE & 128) ? 1 : 0)) || (kargs()->force != 0)};
            pg8::gemm_phase<pg8::EpiOut, pg8::StaticOrder, true, true>(lds + RING_OFF, g, S, E);
        }
#endif
        GRID_BAR();
        if (!SKIP(256)) for (int rep = 0; rep < ((PROBE & 256) ? 2 : 1); ++rep)
        for (int m = gw; m < M; m += 4 * NGW) ln_rows<4>(H, m, NGW, M, kargs()->ln_post_g + l * D, kargs()->ln_post_b + l * D, H, XN, lane, (rep == ((PROBE & 256) ? 1 : 0)) || (kargs()->force != 0));
        if (l + 1 < DEPTH) GRID_BAR();
        if (PROBE & 1) { for (int i = 0; i < 6; ++i) GRID_BAR(); }
    }
    }
}

extern "C" void kernel_launch(void* const* d_in, const int* in_sizes, int n_in, void* d_out, int out_size, void* d_ws, size_t ws_size, hipStream_t stream) {
    static int grid = 0;
    if (grid == 0) {
        if (n_in != 19 || in_sizes[0] != M * D || out_size != M * D || ws_size < WS_END) { fprintf(stderr, "kernel_launch: unexpected shapes (n_in %d, in0 %d, out %d, ws %zu); nothing launched\n", n_in, n_in > 0 ? in_sizes[0] : -1, out_size, ws_size); grid = -1; return; }
        int dev = 0, cus = 0, per_cu = 0;
        if (hipGetDevice(&dev) != hipSuccess || hipDeviceGetAttribute(&cus, hipDeviceAttributeMultiprocessorCount, dev) != hipSuccess) { grid = -1; return; }
        if (hipFuncSetAttribute((const void*)mega_fwd, hipFuncAttributeMaxDynamicSharedMemorySize, LDS_BYTES) != hipSuccess) { fprintf(stderr, "kernel_launch: hipFuncSetAttribute failed\n"); grid = -1; return; }
        if (hipOccupancyMaxActiveBlocksPerMultiprocessor(&per_cu, (const void*)mega_fwd, NWAVES * 64, LDS_BYTES) != hipSuccess || per_cu < 1) { fprintf(stderr, "kernel_launch: occupancy query reports %d\n", per_cu); per_cu = 1; }
        (void)hipGetLastError();
        grid = cus * per_cu;
    }
    if (grid < 0) return;
    Args a{};
    const float** f = (const float**)&a;
    for (int i = 0; i < 19; ++i) f[i] = (const float*)d_in[i];
    a.out = (float*)d_out; a.ws = (unsigned char*)d_ws;
    void* args[] = {&a};
    const hipError_t e = hipLaunchCooperativeKernel((const void*)mega_fwd, dim3(grid), dim3(NWAVES * 64), args, LDS_BYTES, stream);
    if (e != hipSuccess) fprintf(stderr, "kernel_launch: cooperative launch failed: %s (grid %d)\n", hipGetErrorString(e), grid);
}
```

```cpp
#include <hip/hip_runtime.h>
#include <hip/hip_cooperative_groups.h>
#include <cstdio>
#include <cstdint>
namespace cg = cooperative_groups;
namespace pg8 {
#define PG8_LAS __attribute__((address_space(3)))
typedef unsigned short bf16_t;
typedef short bf16x8 __attribute__((ext_vector_type(8)));
typedef float f32x4 __attribute__((ext_vector_type(4)));
typedef unsigned u32x4 __attribute__((ext_vector_type(4)));
constexpr int BM = 256, BK = 64, HALF = 128, HTB = HALF * BK * 2  , STAGE_BYTES = 8 * HTB, NXCD = 8, WGM = 8;

__host__ __device__ __forceinline__ int lds_byte(int r, int c) { const int st = (r >> 4) * 2 + (c >> 5), rr = r & 15, cc = c & 31, ob = rr * 64 + cc * 2; return st * 1024 + (ob ^ (((ob >> 9) & 1) << 5)); }
__host__ __device__ __forceinline__ void stage_rc(int b, int& R, int& C) { const int st = b / 1024, sb = b % 1024, swz = sb ^ (((sb >> 9) & 1) << 5); R = (st >> 1) * 16 + swz / 64; C = (st & 1) * 32 + (swz % 64) / 2; }
__host__ __device__ __forceinline__ int perm32(int rho) { const int n = rho >> 4, i = rho & 15; return 8 * (i >> 2) + 4 * n + (i & 3); }

struct Unit { int pm, pn; };
struct Gemm { const bf16_t* A; const bf16_t* Bt; int M, N, K, lda, ldb; };

struct StaticOrder {
    int nM, nN, nwg, G, c;
    __host__ __device__ void init(int M, int N, int G_, int c_) { nM = M / BM; nN = N / BM; nwg = nM * nN; G = G_; c = c_; }
    __host__ __device__ bool next(int i, Unit& u) const {
        const long L = (long)i * G + c; if (L >= nwg) return false;
        int wgid = (int)L; { const int q = nwg / NXCD, r = nwg % NXCD, xcd = wgid % NXCD, off = wgid / NXCD; wgid = (xcd < r ? xcd * (q + 1) : r * (q + 1) + (xcd - r) * q) + off; }
        const int nig = WGM * nN, gid = wgid / nig, fm = gid * WGM, gsz = (nM - fm) < WGM ? (nM - fm) : WGM;
        u.pm = fm + ((wgid % nig) % gsz); u.pn = (wgid % nig) / gsz; return true;
    }
    __device__ __forceinline__ void a_ready(const Unit&) const {}
    __device__ __forceinline__ void done(const Unit&) const {}
};

__device__ __forceinline__ unsigned cvt_pk_bf16(float lo, float hi) { unsigned r; asm volatile("v_cvt_pk_bf16_f32 %0, %1, %2" : "=v"(r) : "v"(lo), "v"(hi)); return r; }
__device__ __forceinline__ float bf_lo(unsigned w) { return __uint_as_float(w << 16); }
__device__ __forceinline__ float bf_hi(unsigned w) { return __uint_as_float(w & 0xffff0000u); }
constexpr float LOG2E = 1.4426950408889634f;
constexpr float C2 = 0.125f * LOG2E;
__device__ __forceinline__ float sigmoid_f(float x) { return __builtin_amdgcn_rcpf(1.0f + __builtin_amdgcn_exp2f(-x * LOG2E)); }

struct EpiIn {
    static constexpr bool PERM = true, AFTER_DRAIN = false, MIDHOOK = false;
    bf16_t* QU; bf16_t* REST; const float* biasv; const float* qg; const float* kg;
    __device__ __forceinline__ void operator()(const f32x4 (&acc)[2][2][4][2], const Unit& u, int wr, int wc, int fr, int fq) const {
        const int vt = u.pn;
        const int vc0 = vt * 256 + wc * 64 + fq * 8;
        bf16_t* dst; int pitch, dcol;
        if (vt < 6) { dst = QU; pitch = 1536; dcol = vc0; } else { dst = REST; pitch = 3328; dcol = vc0 - 1536; }
        int type = 0; float sc = 1.f; const float* ng = qg;
        if (vt < 2) sc = C2;
        else if (vt < 4) { type = 3; sc = C2; }
        else if (vt == 10 || vt == 11 || vt == 13 || vt == 14 || vt == 17 || vt == 18) type = 1;
        else if (vt == 12) { if (wc < 2) { type = 3; ng = kg; } }
        f32x4 bv[2][2];
#pragma unroll
        for (int bj = 0; bj < 2; ++bj)
#pragma unroll
            for (int n = 0; n < 2; ++n) bv[bj][n] = *(const f32x4*)(biasv + vc0 + bj * 32 + 4 * n);
        const int row0 = u.pm * BM + wr * 64 + fr;
        if (type == 3) {
#pragma unroll
            for (int ai = 0; ai < 2; ++ai)
#pragma unroll
                for (int m = 0; m < 4; ++m) {
                    asm volatile("" ::: "memory");
                    int fqo = fq; asm volatile("" : "+v"(fqo));
                    const float* bp = biasv + vt * 256 + wc * 64 + fqo * 8; const float* gp = ng + fqo * 8;
                    const int row = row0 + ai * HALF + m * 16; const int s = row & 2047; const float pr = (float)(s >> 6), pc = (float)(s & 63);
                    float ss = 0.f;
#pragma unroll
                    for (int bj = 0; bj < 2; ++bj)
#pragma unroll
                        for (int n = 0; n < 2; ++n) { const f32x4 v = acc[ai][bj][m][n] + *(const f32x4*)(bp + bj * 32 + 4 * n); ss += (v[0] * v[0] + v[1] * v[1]) + (v[2] * v[2] + v[3] * v[3]); }
                    ss += __shfl_xor(ss, 16); ss += __shfl_xor(ss, 32);
                    const float rs = __builtin_amdgcn_rsqf(ss * (1.0f / 64.0f) + 1e-6f);
                    bf16_t* rowp = dst + (size_t)row * pitch + dcol;
#pragma unroll
                    for (int bj = 0; bj < 2; ++bj) { const float pos = bj ? pc : pr; u32x4 w;
#pragma unroll
                        for (int n = 0; n < 2; ++n) { const f32x4 v = (acc[ai][bj][m][n] + *(const f32x4*)(bp + bj * 32 + 4 * n)) * rs * *(const f32x4*)(gp + bj * 32 + 4 * n);
#pragma unroll
                            for (int h = 0; h < 2; ++h) { const float fr_ = __builtin_amdgcn_exp2f(-(float)(4 * fqo + 2 * n + h) * 0.8304820237218407f) * 0.15915494309189535f;
                                const float ang = pos * fr_; const float c = __builtin_amdgcn_cosf(ang), sn = __builtin_amdgcn_sinf(ang);
                                w[2 * n + h] = cvt_pk_bf16((v[2 * h] * c - v[2 * h + 1] * sn) * sc, (v[2 * h] * sn + v[2 * h + 1] * c) * sc); } }
                        *(u32x4*)(rowp + bj * 32) = w; }
                    __builtin_amdgcn_sched_barrier(0);
                }
        } else {
#pragma unroll
            for (int ai = 0; ai < 2; ++ai)
#pragma unroll
                for (int m = 0; m < 4; ++m) { bf16_t* rowp = dst + (size_t)(row0 + ai * HALF + m * 16) * pitch + dcol;
#pragma unroll
                    for (int bj = 0; bj < 2; ++bj) { f32x4 v0 = acc[ai][bj][m][0] + bv[bj][0], v1 = acc[ai][bj][m][1] + bv[bj][1];
                        if (type == 1) {
#pragma unroll
                            for (int e = 0; e < 4; ++e) { v0[e] *= sigmoid_f(v0[e]); v1[e] *= sigmoid_f(v1[e]); } }
                        else { v0 = v0 * sc; v1 = v1 * sc; }
                        u32x4 w; w.x = cvt_pk_bf16(v0[0], v0[1]); w.y = cvt_pk_bf16(v0[2], v0[3]); w.z = cvt_pk_bf16(v1[0], v1[1]); w.w = cvt_pk_bf16(v1[2], v1[3]);
                        *(u32x4*)(rowp + bj * 32) = w; } }
        }
    }
};

struct EpiGate {
    static constexpr bool PERM = true, AFTER_DRAIN = false, MIDHOOK = false;
    bf16_t* G; const float* biasv;
    __device__ __forceinline__ void operator()(const f32x4 (&acc)[2][2][4][2], const Unit& u, int wr, int wc, int fr, int fq) const {
        const int vc0 = u.pn * 256 + wc * 64 + fq * 8;
        f32x4 bv[2][2];
#pragma unroll
        for (int bj = 0; bj < 2; ++bj)
#pragma unroll
            for (int n = 0; n < 2; ++n) bv[bj][n] = *(const f32x4*)(biasv + vc0 + bj * 32 + 4 * n);
        const int row0 = u.pm * BM + wr * 64 + fr;
#pragma unroll
        for (int ai = 0; ai < 2; ++ai)
#pragma unroll
            for (int m = 0; m < 4; ++m) { bf16_t* rowp = G + (size_t)(row0 + ai * HALF + m * 16) * 3072 + vc0;
#pragma unroll
                for (int bj = 0; bj < 2; ++bj) { f32x4 v0 = acc[ai][bj][m][0] + bv[bj][0], v1 = acc[ai][bj][m][1] + bv[bj][1];
#pragma unroll
                    for (int e = 0; e < 4; ++e) { v0[e] = fmaxf(sigmoid_f(v0[e]), 1e-30f); v1[e] = fmaxf(sigmoid_f(v1[e]), 1e-30f); }
                    u32x4 w; w.x = cvt_pk_bf16(v0[0], v0[1]); w.y = cvt_pk_bf16(v0[2], v0[3]); w.z = cvt_pk_bf16(v1[0], v1[1]); w.w = cvt_pk_bf16(v1[2], v1[3]);
                    *(u32x4*)(rowp + bj * 32) = w; } }
    }
};

struct EpiMerge {
    static constexpr bool PERM = true, AFTER_DRAIN = false, MIDHOOK = true;
    const bf16_t* G; bf16_t* O;
    __device__ __forceinline__ void mid(f32x4 (&acc)[2][2][4][2], const Unit& u, int seg, int wr, int wc, int fr, int fq) const {
        const int row0 = u.pm * BM + wr * 64 + fr, col0 = u.pn * BM + wc * 32 + 8 * fq;
        const bf16_t* gp = G + (size_t)row0 * 3072 + (seg - 1) * 1024 + col0;
#pragma unroll
        for (int ai = 0; ai < 2; ++ai)
#pragma unroll
            for (int m = 0; m < 4; ++m)
#pragma unroll
                for (int bj = 0; bj < 2; ++bj) { const bf16_t* p = gp + (size_t)(ai * HALF + m * 16) * 3072 + bj * HALF;
                    const u32x4 ga = *(const u32x4*)p, gb = *(const u32x4*)(p + 1024);
#pragma unroll
                    for (int e = 0; e < 2; ++e) {
                        acc[ai][bj][m][0][2 * e] *= bf_lo(ga[e]) * __builtin_amdgcn_rcpf(bf_lo(gb[e])); acc[ai][bj][m][0][2 * e + 1] *= bf_hi(ga[e]) * __builtin_amdgcn_rcpf(bf_hi(gb[e]));
                        acc[ai][bj][m][1][2 * e] *= bf_lo(ga[2 + e]) * __builtin_amdgcn_rcpf(bf_lo(gb[2 + e])); acc[ai][bj][m][1][2 * e + 1] *= bf_hi(ga[2 + e]) * __builtin_amdgcn_rcpf(bf_hi(gb[2 + e])); } }
    }
    __device__ __forceinline__ void operator()(const f32x4 (&acc)[2][2][4][2], const Unit& u, int wr, int wc, int fr, int fq) const {
        const int row0 = u.pm * BM + wr * 64 + fr, col0 = u.pn * BM + wc * 32 + 8 * fq;
#pragma unroll
        for (int ai = 0; ai < 2; ++ai)
#pragma unroll
            for (int m = 0; m < 4; ++m)
#pragma unroll
                for (int bj = 0; bj < 2; ++bj) { const size_t r = (size_t)(row0 + ai * HALF + m * 16);
                    const u32x4 g2 = *(const u32x4*)(G + r * 3072 + 2048 + col0 + bj * HALF);
                    const f32x4 a0 = acc[ai][bj][m][0], a1 = acc[ai][bj][m][1]; u32x4 w;
                    w.x = cvt_pk_bf16(a0[0] * bf_lo(g2.x), a0[1] * bf_hi(g2.x)); w.y = cvt_pk_bf16(a0[2] * bf_lo(g2.y), a0[3] * bf_hi(g2.y));
                    w.z = cvt_pk_bf16(a1[0] * bf_lo(g2.z), a1[1] * bf_hi(g2.z)); w.w = cvt_pk_bf16(a1[2] * bf_lo(g2.w), a1[3] * bf_hi(g2.w));
                    *(u32x4*)(O + r * 1024 + col0 + bj * HALF) = w; }
    }
};

struct EpiOut {
    static constexpr bool PERM = false, AFTER_DRAIN = false, MIDHOOK = false;
    float* H; const float* bias; float alpha; bool wr_en;
    __device__ __forceinline__ void operator()(const f32x4 (&acc)[2][2][4][2], const Unit& u, int wr, int wc, int fr, int fq) const {
        const int row0 = u.pm * BM + wr * 64 + fr, col0 = u.pn * BM + wc * 32 + 4 * fq;
        f32x4 bv[2][2];
#pragma unroll
        for (int bj = 0; bj < 2; ++bj)
#pragma unroll
            for (int n = 0; n < 2; ++n) bv[bj][n] = *(const f32x4*)(bias + col0 + bj * HALF + n * 16);
#pragma unroll
        for (int ai = 0; ai < 2; ++ai)
#pragma unroll
            for (int m = 0; m < 4; ++m) { float* rowp = H + (size_t)(row0 + ai * HALF + m * 16) * 1024 + col0;
#pragma unroll
                for (int bj = 0; bj < 2; ++bj)
#pragma unroll
                    for (int n = 0; n < 2; ++n) { float* p = rowp + bj * HALF + n * 16; const f32x4 hv = *(const f32x4*)p; const f32x4 r_ = hv * alpha + acc[ai][bj][m][n] + bv[bj][n]; if (wr_en) *(f32x4*)p = r_; } }
    }
};
template <class Epi, class Sched, bool ALIGN_EPI = false, bool SP2 = false>
__device__ __forceinline__ void gemm_phase(PG8_LAS unsigned char* lds, const Gemm g, const Sched& S, const Epi& E) {
    int tid_ = threadIdx.x; asm volatile("" : "+v"(tid_));
    const int tid = tid_, wid = __builtin_amdgcn_readfirstlane(tid >> 6), lane = tid & 63, wr = wid >> 2, wc = wid & 3, fr = lane & 15, fq = lane >> 4;
    const int K = g.K, nt = K / BK;
    unsigned voffA[2], voffB[2];
#pragma unroll
    for (int i = 0; i < 2; ++i) { int R, C; stage_rc(tid * 16 + i * 8192, R, C); const int Rb = Epi::PERM ? ((R & ~31) + perm32(R & 31)) : R;
        voffA[i] = (unsigned)(R * g.lda + C) * 2u; voffB[i] = (unsigned)(Rb * g.ldb + C) * 2u; }
    const size_t kstep = (size_t)(BK * 2);
    const size_t hstepA = (size_t)HALF * g.lda * 2, hstepB = (size_t)HALF * g.ldb * 2;
    const size_t tstepA = 2 * hstepA, tstepB = 2 * hstepB;
    const unsigned ldsw = (unsigned)wid * 1024u;
    const int aoff = lds_byte(wr * 64 + fr, fq * 8), boff = lds_byte(wc * 32 + fr, fq * 8);
#define PG8_SA(b, h) (((b) * 2 + (h)) * HTB)
#define PG8_SB(b, h) ((4 + (b) * 2 + (h)) * HTB)
#define PG8_STAGE(bufoff, gbase, voff) do { _Pragma("unroll") for (int _i = 0; _i < 2; ++_i) \
        __builtin_amdgcn_global_load_lds((const unsigned*)((const char*)(gbase) + (voff)[_i]), (PG8_LAS unsigned*)(lds + (bufoff) + ldsw + _i * 8192), 16, 0, 0); } while (0)
#define PG8_LDA(dst, b, h) do { _Pragma("unroll") for (int m = 0; m < 4; ++m) _Pragma("unroll") for (int k = 0; k < 2; ++k) dst[m][k] = *(const PG8_LAS bf16x8*)(lds + PG8_SA(b, h) + aoff + m * 2048 + k * 1024); } while (0)
#define PG8_LDB(dst, b, h) do { _Pragma("unroll") for (int n = 0; n < 2; ++n) _Pragma("unroll") for (int k = 0; k < 2; ++k) dst[n][k] = *(const PG8_LAS bf16x8*)(lds + PG8_SB(b, h) + boff + n * 2048 + k * 1024); } while (0)
#define PG8_MMA(ai, bj, At, Bt) do { __builtin_amdgcn_s_setprio(1); _Pragma("unroll") for (int m = 0; m < 4; ++m) _Pragma("unroll") for (int n = 0; n < 2; ++n) _Pragma("unroll") for (int k = 0; k < 2; ++k) \
        acc[ai][bj][m][n] = __builtin_amdgcn_mfma_f32_16x16x32_bf16(Bt[n][k], At[m][k], acc[ai][bj][m][n], 0, 0, 0); __builtin_amdgcn_s_setprio(0); } while (0)
#define PG8_WAIT_V(n) asm volatile("s_waitcnt vmcnt(" #n ")" ::: "memory")
#define PG8_WAIT_L(n) asm volatile("s_waitcnt lgkmcnt(" #n ")" ::: "memory")
#define PG8_BAR __builtin_amdgcn_s_barrier()
#define PG8_SCHED __builtin_amdgcn_sched_barrier(0)
    Unit cur, nxt; int ui = 0;
    if (!S.next(0, cur)) return;
    f32x4 acc[2][2][4][2];
#pragma unroll
    for (int a = 0; a < 2; ++a)
#pragma unroll
        for (int b = 0; b < 2; ++b)
#pragma unroll
            for (int m = 0; m < 4; ++m)
#pragma unroll
                for (int n = 0; n < 2; ++n) acc[a][b][m][n] = (f32x4){0.f, 0.f, 0.f, 0.f};
    bf16x8 At[4][2], B0[2][2], B1[2][2];
    const char* cA = (const char*)g.A + (size_t)cur.pm * tstepA; const char* cB = (const char*)g.Bt + (size_t)cur.pn * tstepB;
    S.a_ready(cur);
    if constexpr (SP2) {
        PG8_STAGE(PG8_SB(0, 0), cB, voffB); PG8_STAGE(PG8_SB(0, 1), cB + hstepB, voffB); PG8_STAGE(PG8_SA(0, 0), cA, voffA); PG8_STAGE(PG8_SA(0, 1), cA + hstepA, voffA);
        if (wr == 1) PG8_BAR;
        PG8_WAIT_V(2); PG8_BAR;
        PG8_STAGE(PG8_SB(1, 0), cB + kstep, voffB); PG8_STAGE(PG8_SA(1, 0), cA + kstep, voffA); PG8_STAGE(PG8_SB(1, 1), cB + hstepB + kstep, voffB);
        PG8_WAIT_V(6); PG8_BAR;
    } else {
        PG8_STAGE(PG8_SB(0, 0), cB, voffB); PG8_STAGE(PG8_SA(0, 0), cA, voffA); PG8_STAGE(PG8_SB(0, 1), cB + hstepB, voffB); PG8_STAGE(PG8_SA(0, 1), cA + hstepA, voffA);
        if (wr == 1) PG8_BAR;
        PG8_WAIT_V(4); PG8_BAR;
        PG8_STAGE(PG8_SB(1, 0), cB + kstep, voffB); PG8_STAGE(PG8_SA(1, 0), cA + kstep, voffA); PG8_STAGE(PG8_SB(1, 1), cB + hstepB + kstep, voffB);
        PG8_WAIT_V(6); PG8_BAR;
    }
    for (;;) {
        const bool has_next = S.next(ui + 1, nxt);
        const char* nA = has_next ? (const char*)g.A + (size_t)nxt.pm * tstepA : cA; const char* nB = has_next ? (const char*)g.Bt + (size_t)nxt.pn * tstepB : cB;
        for (int t = 0; t < nt; t += 2) {
            const bool last = (t == nt - 2);
            const char* a1 = cA + (size_t)(t + 1) * kstep;
            const char* a2 = last ? nA : cA + (size_t)(t + 2) * kstep; const char* b2 = last ? nB : cB + (size_t)(t + 2) * kstep;
            const char* a3 = a2 + kstep; const char* b3 = b2 + kstep;
            if (last && has_next) S.a_ready(nxt);
            if constexpr (Epi::MIDHOOK) { if (t == 8 || t == 16) E.mid(acc, cur, t >> 3, wr, wc, fr, fq); }
            if constexpr (SP2) {
            PG8_LDB(B0, 0, 0); PG8_LDB(B1, 0, 1); PG8_SCHED; PG8_LDA(At, 0, 0); PG8_STAGE(PG8_SA(1, 1), a1 + hstepA, voffA);
            PG8_WAIT_V(8); PG8_WAIT_L(0); PG8_BAR; PG8_MMA(0, 0, At, B0); PG8_MMA(0, 1, At, B1); PG8_BAR; PG8_SCHED;
            PG8_LDA(At, 0, 1); PG8_STAGE(PG8_SB(0, 0), b2, voffB); PG8_STAGE(PG8_SB(0, 1), b2 + hstepB, voffB); PG8_STAGE(PG8_SA(0, 0), a2, voffA);
            PG8_WAIT_V(8); PG8_WAIT_L(0); PG8_BAR; PG8_MMA(1, 0, At, B0); PG8_MMA(1, 1, At, B1); PG8_BAR; PG8_SCHED;
            PG8_LDB(B0, 1, 0); PG8_LDB(B1, 1, 1); PG8_SCHED; PG8_LDA(At, 1, 0); PG8_STAGE(PG8_SA(0, 1), a2 + hstepA, voffA);
            PG8_WAIT_V(8); PG8_WAIT_L(0); PG8_BAR; PG8_MMA(0, 0, At, B0); PG8_MMA(0, 1, At, B1); PG8_BAR; PG8_SCHED;
            PG8_LDA(At, 1, 1); PG8_STAGE(PG8_SB(1, 0), b3, voffB); PG8_STAGE(PG8_SB(1, 1), b3 + hstepB, voffB); PG8_STAGE(PG8_SA(1, 0), a3, voffA);
            PG8_WAIT_V(8); PG8_WAIT_L(0); PG8_BAR; PG8_MMA(1, 0, At, B0); PG8_MMA(1, 1, At, B1); PG8_BAR; PG8_SCHED;
            } else {
            PG8_LDB(B0, 0, 0); PG8_SCHED; PG8_LDA(At, 0, 0); PG8_STAGE(PG8_SA(1, 1), a1 + hstepA, voffA);
            PG8_WAIT_L(8); PG8_BAR; PG8_WAIT_L(0); PG8_MMA(0, 0, At, B0); PG8_BAR; PG8_SCHED;
            PG8_LDB(B1, 0, 1); PG8_STAGE(PG8_SB(0, 0), b2, voffB);
            PG8_BAR; PG8_WAIT_L(0); PG8_MMA(0, 1, At, B1); PG8_BAR;
            PG8_LDA(At, 0, 1); PG8_STAGE(PG8_SA(0, 0), a2, voffA);
            PG8_BAR; PG8_WAIT_L(0); PG8_MMA(1, 0, At, B0); PG8_BAR; PG8_SCHED;
            PG8_STAGE(PG8_SB(0, 1), b2 + hstepB, voffB);
            PG8_WAIT_V(6); PG8_BAR; PG8_MMA(1, 1, At, B1); PG8_BAR;
            PG8_LDB(B0, 1, 0); PG8_SCHED; PG8_LDA(At, 1, 0); PG8_STAGE(PG8_SA(0, 1), a2 + hstepA, voffA);
            PG8_WAIT_L(8); PG8_BAR; PG8_WAIT_L(0); PG8_MMA(0, 0, At, B0); PG8_BAR; PG8_SCHED;
            PG8_LDB(B1, 1, 1); PG8_STAGE(PG8_SB(1, 0), b3, voffB);
            PG8_BAR; PG8_WAIT_L(0); PG8_MMA(0, 1, At, B1); PG8_BAR;
            PG8_LDA(At, 1, 1); PG8_STAGE(PG8_SA(1, 0), a3, voffA);
            PG8_BAR; PG8_WAIT_L(0); PG8_MMA(1, 0, At, B0); PG8_BAR; PG8_SCHED;
            PG8_STAGE(PG8_SB(1, 1), b3 + hstepB, voffB);
            PG8_WAIT_V(6); PG8_BAR; PG8_MMA(1, 1, At, B1); PG8_BAR;
            }
        }
        if constexpr (ALIGN_EPI) { if (wr == 0) PG8_BAR; }
        if constexpr (!Epi::AFTER_DRAIN) { E(acc, cur, wr, wc, fr, fq); S.done(cur); }
        if (!has_next) break;
#pragma unroll
        for (int a = 0; a < 2; ++a)
#pragma unroll
            for (int b = 0; b < 2; ++b)
#pragma unroll
                for (int m = 0; m < 4; ++m)
#pragma unroll
                    for (int n = 0; n < 2; ++n) acc[a][b][m][n] = (f32x4){0.f, 0.f, 0.f, 0.f};
        cur = nxt; cA = nA; cB = nB; ++ui;
        if constexpr (ALIGN_EPI) { if (wr == 1) PG8_BAR; }
    }
    PG8_WAIT_V(0);
    if constexpr (!ALIGN_EPI) { if (wr == 0) PG8_BAR; }
    PG8_BAR;
    if constexpr (Epi::AFTER_DRAIN) { E.fused(acc, cur, wr, wc, fr, fq, lds, wid, lane); S.done(cur); }
#undef PG8_SA
#undef PG8_SB
#undef PG8_STAGE
#undef PG8_LDA
#undef PG8_LDB
#undef PG8_MMA
#undef PG8_WAIT_V
#undef PG8_WAIT_L
#undef PG8_BAR
#undef PG8_SCHED
}
}
#include <hip/hip_bf16.h>
#include <cmath>
namespace attn_body {
using bf16=__hip_bfloat16;
using bf16x8=__attribute__((ext_vector_type(8)))short;
using s16x4=__attribute__((ext_vector_type(4)))short;
using f32x16=__attribute__((ext_vector_type(16)))float;
using u32x4=__attribute__((ext_vector_type(4)))unsigned;
constexpr int BATCH=8,NHEAD=8,SEQ=2048,D=64,QP=1536,KP=3328;
constexpr int NW=8,QBLK=32,QB=QBLK*NW,KVBLK=64,NQB=SEQ/QB;
constexpr int ATTN_UNIT_ROWS=QB;
__device__ __forceinline__ int crow(int r,int hi){return (r&3)+8*(r>>2)+4*hi;}
#define SBAR() __builtin_amdgcn_sched_barrier(0)
__device__ __forceinline__ void cmask(f32x16&p0,f32x16&p1,int jb,int qrel,int hi){
  const float NEG=-INFINITY; int kb=64*jb+4*hi;
  #pragma unroll
  for(int r=0;r<16;++r){int kv=kb+(r&3)+8*(r>>2); if(kv>qrel)p0[r]=NEG; if(kv+32>qrel)p1[r]=NEG;}
}

constexpr int NSLOT=3, SLOTB=8192;
constexpr int LDS_K=0, LDS_V=NSLOT*SLOTB, LDS_WS=2*NSLOT*SLOTB, LDS_OST=LDS_WS+NW*64*4, LDS_BYTES=LDS_OST+NW*4096;
constexpr float C2=0.125f*1.4426950408889634f;
__device__ __forceinline__ void glds16(const void*gsrc,unsigned lds_dst){unsigned keep;
  asm volatile("s_mov_b32 %0, m0\n\ts_mov_b32 m0, %2\n\ts_nop 0\n\tglobal_load_lds_dwordx4 %1, off\n\ts_mov_b32 m0, %0":"=&s"(keep):"v"(gsrc),"s"(lds_dst):"memory");}
__device__ __forceinline__ float max3f(float a,float b,float c){float r;asm("v_max3_f32 %0, %1, %2, %3":"=v"(r):"v"(a),"v"(b),"v"(c));return r;}
__device__ __forceinline__ float max2f(float a,float b){float r;asm("v_max_f32_e32 %0, %1, %2":"=v"(r):"v"(a),"v"(b));return r;}
__device__ __forceinline__ float fadd_s(float a,float b){float r;asm("v_add_f32_e32 %0, %1, %2":"=v"(r):"v"(a),"v"(b));return r;}
__device__ __forceinline__ float fsub_s(float a,float b){float r;asm("v_sub_f32_e32 %0, %1, %2":"=v"(r):"v"(a),"v"(b));return r;}
typedef float f32x2_t __attribute__((ext_vector_type(2))); typedef __bf16 bf16x2_t __attribute__((ext_vector_type(2)));
__device__ __forceinline__ unsigned cvtpk_s(float lo,float hi){f32x2_t v={lo,hi};bf16x2_t b=__builtin_convertvector(v,bf16x2_t);return __builtin_bit_cast(unsigned,b);}
#define WAIT_BAR(N) asm volatile("s_waitcnt vmcnt(" #N ") lgkmcnt(0)\n\ts_barrier":::"memory")

__device__ __forceinline__ void qkt(f32x16&p0,f32x16&p1,const char*Kslot,const bf16x8*qr,const f32x16&negm,int r32,int hi){
  const char*kb=Kslot+hi*1024+r32*16;
  #pragma unroll
  for(int d0=0;d0<4;++d0){
    const bf16x8 b0=*reinterpret_cast<const bf16x8*>(kb+d0*2048);
    const bf16x8 b1=*reinterpret_cast<const bf16x8*>(kb+d0*2048+512);
    if(d0==0){p0=__builtin_amdgcn_mfma_f32_32x32x16_bf16(b0,qr[0],negm,0,0,0);p1=__builtin_amdgcn_mfma_f32_32x32x16_bf16(b1,qr[0],negm,0,0,0);}
    else{p0=__builtin_amdgcn_mfma_f32_32x32x16_bf16(b0,qr[d0],p0,0,0,0);p1=__builtin_amdgcn_mfma_f32_32x32x16_bf16(b1,qr[d0],p1,0,0,0);}}
}
typedef __attribute__((address_space(3))) const char* lds_cptr;
typedef short v4i16_t __attribute__((ext_vector_type(4)));
__device__ __forceinline__ void kload8(bf16x8*kf,lds_cptr kp){
  kf[0]=*(const __attribute__((address_space(3))) bf16x8*)(kp);      kf[1]=*(const __attribute__((address_space(3))) bf16x8*)(kp+512);
  kf[2]=*(const __attribute__((address_space(3))) bf16x8*)(kp+2048); kf[3]=*(const __attribute__((address_space(3))) bf16x8*)(kp+2560);
  kf[4]=*(const __attribute__((address_space(3))) bf16x8*)(kp+4096); kf[5]=*(const __attribute__((address_space(3))) bf16x8*)(kp+4608);
  kf[6]=*(const __attribute__((address_space(3))) bf16x8*)(kp+6144); kf[7]=*(const __attribute__((address_space(3))) bf16x8*)(kp+6656);
}
__device__ __forceinline__ void kload2(bf16x8*kf,lds_cptr kp,int j){ kf[2*j]=*(const __attribute__((address_space(3))) bf16x8*)(kp+j*2048); kf[2*j+1]=*(const __attribute__((address_space(3))) bf16x8*)(kp+j*2048+512); }
__device__ __forceinline__ s16x4 vtr(lds_cptr p){ return __builtin_bit_cast(s16x4,__builtin_amdgcn_ds_read_tr16_b64_v4i16((__attribute__((address_space(3))) v4i16_t*)p)); }
__device__ __forceinline__ float rowmax(const f32x16&p0,const f32x16&p1){
  float a=max3f(p0[0],p0[1],p1[0]),b=max3f(p0[2],p0[3],p1[1]);a=max3f(a,p1[2],p1[3]);
  #pragma unroll
  for(int r=4;r<16;r+=4){a=max3f(a,p0[r],p0[r+1]);b=max3f(b,p0[r+2],p0[r+3]);a=max3f(a,p1[r],p1[r+1]);b=max3f(b,p1[r+2],p1[r+3]);}
  const float m=max2f(a,b);
  auto rr=__builtin_amdgcn_permlane32_swap(__float_as_uint(m),__float_as_uint(m),false,false);
  return max2f(__uint_as_float(rr[0]),__uint_as_float(rr[1]));
}
__device__ __forceinline__ void pv(f32x16*o,int vb,bf16x8 pa0,bf16x8 pa1,bf16x8 pa2,bf16x8 pa3){
  #pragma unroll
  for(int d0=0;d0<2;++d0){s16x4 lo[4],hi[4];
    #pragma unroll
    for(int ks=0;ks<4;++ks){
      asm volatile("ds_read_b64_tr_b16 %0,%1 offset:%c2":"=&v"(lo[ks]):"v"(vb),"i"(d0*4096+ks*1024):"memory");
      asm volatile("ds_read_b64_tr_b16 %0,%1 offset:%c2":"=&v"(hi[ks]):"v"(vb),"i"(d0*4096+ks*1024+512):"memory");}
    asm volatile("s_waitcnt lgkmcnt(0)":::"memory");SBAR();
    #define PK(k) (bf16x8){lo[k][0],lo[k][1],lo[k][2],lo[k][3],hi[k][0],hi[k][1],hi[k][2],hi[k][3]}
    o[d0]=__builtin_amdgcn_mfma_f32_32x32x16_bf16(pa0,PK(0),o[d0],0,0,0);
    o[d0]=__builtin_amdgcn_mfma_f32_32x32x16_bf16(pa1,PK(1),o[d0],0,0,0);
    o[d0]=__builtin_amdgcn_mfma_f32_32x32x16_bf16(pa2,PK(2),o[d0],0,0,0);
    o[d0]=__builtin_amdgcn_mfma_f32_32x32x16_bf16(pa3,PK(3),o[d0],0,0,0);
    #undef PK
  }
}

#ifndef ATTN_STORE16
#define ATTN_STORE16(p,v) (*(u32x4*)(p)=(v))
#endif
template<int THRL> __device__ __forceinline__ void attn_unit(int b,int h,int kvh,int qb,const bf16*Q,const bf16*__restrict__ K,const bf16*__restrict__ V,const bf16*__restrict__ Z,bf16*O,char*shm,bool wr_en){
  int tid_=threadIdx.x; asm volatile("":"+v"(tid_)); const int tid=tid_,lane=tid&63,r32=lane&31,hi=lane>>5; const int wid=__builtin_amdgcn_readfirstlane(tid>>6);
  const long rowbase=(long)b*SEQ; const int q0=qb*QB;
  const bf16*Qw=Q+(rowbase+q0+wid*QBLK)*QP+h*D;
  const bf16*Kh=K+rowbase*KP+kvh*D,*Vh=V+rowbase*KP+kvh*D;
  const unsigned lds0=(unsigned)(uintptr_t)shm;
  float*wsf=(float*)(shm+LDS_WS)+wid*64;
  const bf16*ksrc=Kh+(long)lane*KP+wid*8;
  const bf16*vsrc=Vh+(long)(16*(wid&3)+(lane>>2))*KP+(wid>>2)*32+(lane&3)*8;
  const unsigned kdst=lds0+LDS_K+wid*1024, vdst=lds0+LDS_V+wid*1024;
  #define DMA_K(t,slot) glds16(ksrc+(long)(t)*KVBLK*KP,(unsigned)__builtin_amdgcn_readfirstlane(kdst+(slot)))
  #define DMA_V(t,slot) glds16(vsrc+(long)(t)*KVBLK*KP,(unsigned)__builtin_amdgcn_readfirstlane(vdst+(slot)))
  const int vb0=(int)(lds0+LDS_V)+((lane>>4)&1)*32+(lane&3)*8+(4*hi+((lane&15)>>2))*64;
  const char*Kbase=shm+LDS_K; bf16x8 kf[8];
  const lds_cptr shm3=(lds_cptr)shm; const lds_cptr kp0=shm3+LDS_K+hi*1024+r32*16; const lds_cptr vp0=shm3+LDS_V+((lane>>4)&1)*32+(lane&3)*8+(4*hi+((lane&15)>>2))*64;
  const int NT=SEQ/KVBLK;
  DMA_K(0,0);DMA_V(0,0);DMA_K(1,SLOTB);
  bf16x8 qr[4];
  #pragma unroll
  for(int d0=0;d0<4;++d0)qr[d0]=*reinterpret_cast<const bf16x8*>(&Qw[(long)r32*QP+d0*16+hi*8]);
  float mhat=0.f,l_reg=0.f;f32x16 o[2];o[0]=f32x16{};o[1]=f32x16{};f32x16 negm=f32x16{};asm volatile("":"+v"(negm));

  #define CMASK(P0,P1,t) do{}while(0)
  bool resc=false;
  #define START(P0,P1) do{ const float rm=rowmax(P0,P1); resc=false; \
    { const float dl=rm; mhat=fadd_s(mhat,dl); \
      _Pragma("unroll") for(int r=0;r<16;++r){P0[r]=fsub_s(P0[r],dl);P1[r]=fsub_s(P1[r],dl);} \
      _Pragma("unroll") for(int r=0;r<16;++r)negm[r]=-mhat; asm volatile("":"+v"(negm)); } \
    _Pragma("unroll") for(int r=0;r<16;++r)P0[r]=__builtin_amdgcn_exp2f(P0[r]); }while(0)
  #define RESC() do{ if(resc){ asm volatile("s_waitcnt lgkmcnt(0)":::"memory"); \
      _Pragma("unroll") for(int d_=0;d_<2;++d_) _Pragma("unroll") for(int r=0;r<16;++r)o[d_][r]*=wsf[crow(r,hi)]; } }while(0)
  f32x16 pA0,pA1,pB0,pB1;
  int sl_prev=0,sl_cur=0,sl_next=SLOTB;
  #define ROT() do{sl_prev=sl_cur;sl_cur=sl_next;sl_next=(sl_next==(NSLOT-1)*SLOTB)?0:sl_next+SLOTB;}while(0)
  DMA_K(2,2*SLOTB);
  WAIT_BAR(3);
  qkt(pA0,pA1,Kbase,qr,negm,r32,hi);asm volatile("s_nop 15\n\ts_nop 7":"+v"(pA0),"+v"(pA1));CMASK(pA0,pA1,0);
  START(pA0,pA1);
  _Pragma("unroll") for(int r=0;r<16;++r)pA1[r]=__builtin_amdgcn_exp2f(pA1[r]);
  WAIT_BAR(0);
  DMA_K(3,0);DMA_V(1,SLOTB);
  ROT();
  kload8(kf,kp0+sl_cur);
  WAIT_BAR(2);
  s16x4 vlo[8],vhi[8]; u32x4 pw0,pw1,pw2,pw3;
  #define PKW(P,B) cvtpk_s(P[B],P[B+1])
  #define PAF(k) __builtin_bit_cast(bf16x8,pw##k)
  #define VFR(i) (bf16x8){vlo[i][0],vlo[i][1],vlo[i][2],vlo[i][3],vhi[i][0],vhi[i][1],vhi[i][2],vhi[i][3]}
  #define PIN(x) asm volatile("":"+v"(x))
  #define MX3(a,b,c) __builtin_fmaxf(__builtin_fmaxf((a),(b)),(c))
  #define GAPA(MF,A0,A1,A2,A3,W0,W1,PW) do{ MF; sacc+=A0; sacc+=A1; sacc+=A2; sacc+=A3; PIN(sacc); W0; W1; PIN(PW); SBAR(); }while(0)
  #define EX(v) __builtin_amdgcn_exp2f(v)
  #define GAPB(MF,X,B) do{ MF; X[B]=EX(X[B]); X[B+1]=EX(X[B+1]); X[B+2]=EX(X[B+2]); X[B+3]=EX(X[B+3]); PIN(X); SBAR(); }while(0)
  #define VRD(i) do{ vlo[i]=vtr(vp_+(((i)>>2)*4096+((i)&3)*1024)); vhi[i]=vtr(vp_+(((i)>>2)*4096+((i)&3)*1024+512)); }while(0)
  #define KRD(G,j) do{ if(G){ kload2(kf,kp0+sl_next,j); SBAR(); } }while(0)
  #define STEP(C0,C1,P0,P1,t,GK,GV,GL) do{ SBAR(); \
    const lds_cptr vp_=vp0+sl_prev; \
    VRD(0); SBAR(); float sacc=(P0[0]+P0[1]); \
    GAPA(C0=__builtin_amdgcn_mfma_f32_32x32x16_bf16(kf[0],qr[0],negm,0,0,0), P0[2],P0[3],P0[4],P0[5],     pw0[0]=PKW(P0,0), pw0[1]=PKW(P0,2), pw0); \
    VRD(4); SBAR(); GAPA(C1=__builtin_amdgcn_mfma_f32_32x32x16_bf16(kf[1],qr[0],negm,0,0,0), P0[6],P0[7],P0[8],P0[9],     pw0[2]=PKW(P0,4), pw0[3]=PKW(P0,6), pw0); \
    VRD(1); SBAR(); GAPA(C0=__builtin_amdgcn_mfma_f32_32x32x16_bf16(kf[2],qr[1],C0,0,0,0),   P0[10],P0[11],P0[12],P0[13], pw1[0]=PKW(P0,8), pw1[1]=PKW(P0,10), pw1); \
    VRD(5); SBAR(); GAPA(C1=__builtin_amdgcn_mfma_f32_32x32x16_bf16(kf[3],qr[1],C1,0,0,0),   P0[14],P0[15],P1[0],P1[1],   pw1[2]=PKW(P0,12),pw1[3]=PKW(P0,14), pw1); \
    VRD(2); SBAR(); GAPA(C0=__builtin_amdgcn_mfma_f32_32x32x16_bf16(kf[4],qr[2],C0,0,0,0),   P1[2],P1[3],P1[4],P1[5],     pw2[0]=PKW(P1,0), pw2[1]=PKW(P1,2), pw2); \
    VRD(6); SBAR(); GAPA(C1=__builtin_amdgcn_mfma_f32_32x32x16_bf16(kf[5],qr[2],C1,0,0,0),   P1[6],P1[7],P1[8],P1[9],     pw2[2]=PKW(P1,4), pw2[3]=PKW(P1,6), pw2); \
    VRD(3); SBAR(); GAPA(C0=__builtin_amdgcn_mfma_f32_32x32x16_bf16(kf[6],qr[3],C0,0,0,0),   P1[10],P1[11],P1[12],P1[13], pw3[0]=PKW(P1,8), pw3[1]=PKW(P1,10), pw3); \
    VRD(7); SBAR(); GAPA(C1=__builtin_amdgcn_mfma_f32_32x32x16_bf16(kf[7],qr[3],C1,0,0,0),   P1[14],P1[15],0.f,0.f,       pw3[2]=PKW(P1,12),pw3[3]=PKW(P1,14), pw3); \
    l_reg+=sacc; \
    if(GK){DMA_K((t)+3,sl_cur);} if(GV){DMA_V((t)+1,sl_next);} \
    CMASK(C0,C1,t); \
    { float a=MX3(C0[0],C0[1],C1[0]),b=MX3(C0[2],C0[3],C1[1]); a=MX3(a,C1[2],C1[3]); \
      _Pragma("unroll") for(int r=4;r<16;r+=4){a=MX3(a,C0[r],C0[r+1]);b=MX3(b,C0[r+2],C0[r+3]);a=MX3(a,C1[r],C1[r+1]);b=MX3(b,C1[r+2],C1[r+3]);} \
      float rm=__builtin_fmaxf(a,b); { auto rr=__builtin_amdgcn_permlane32_swap(__float_as_uint(rm),__float_as_uint(rm),false,false); rm=__builtin_fmaxf(__uint_as_float(rr[0]),__uint_as_float(rr[1])); } \
      resc=false; \
      if(__builtin_expect(__any(rm>(float)THRL),0)){ const float dl=__builtin_fmaxf(rm,0.f); mhat+=dl; \
        _Pragma("unroll") for(int r=0;r<16;++r){C0[r]-=dl;C1[r]-=dl;} \
        _Pragma("unroll") for(int r=0;r<16;++r)negm[r]=-mhat; asm volatile("":"+v"(negm)); \
        const float f=__builtin_amdgcn_exp2f(-dl); l_reg*=f; if(hi==0)wsf[r32]=f; resc=true; } } \
    SBAR(); \
    GAPB(o[0]=__builtin_amdgcn_mfma_f32_32x32x16_bf16(PAF(0),VFR(0),o[0],0,0,0), C0,0); \
    GAPB(o[1]=__builtin_amdgcn_mfma_f32_32x32x16_bf16(PAF(0),VFR(4),o[1],0,0,0), C0,4); \
    KRD(GL,0); GAPB(o[0]=__builtin_amdgcn_mfma_f32_32x32x16_bf16(PAF(1),VFR(1),o[0],0,0,0), C0,8); \
    KRD(GL,1); GAPB(o[1]=__builtin_amdgcn_mfma_f32_32x32x16_bf16(PAF(1),VFR(5),o[1],0,0,0), C0,12); \
    KRD(GL,2); GAPB(o[0]=__builtin_amdgcn_mfma_f32_32x32x16_bf16(PAF(2),VFR(2),o[0],0,0,0), C1,0); \
    KRD(GL,3); GAPB(o[1]=__builtin_amdgcn_mfma_f32_32x32x16_bf16(PAF(2),VFR(6),o[1],0,0,0), C1,4); \
    GAPB(o[0]=__builtin_amdgcn_mfma_f32_32x32x16_bf16(PAF(3),VFR(3),o[0],0,0,0), C1,8); \
    GAPB(o[1]=__builtin_amdgcn_mfma_f32_32x32x16_bf16(PAF(3),VFR(7),o[1],0,0,0), C1,12); \
    }while(0)
  int t=1;
  #undef CMASK
  #define CMASK(P0,P1,t) do{}while(0)
  for(;t+5<NT;t+=2){
    STEP(pB0,pB1,pA0,pA1,t,true,true,true);     WAIT_BAR(2); RESC(); ROT();
    STEP(pA0,pA1,pB0,pB1,t+1,true,true,true);   WAIT_BAR(2); RESC(); ROT();
  }
  #undef CMASK
  #define CMASK(P0,P1,t) do{}while(0)
  #define ENDW(tt) do{ if((tt)+3<NT){WAIT_BAR(2);} else if((tt)+2<NT){WAIT_BAR(1);} else {WAIT_BAR(0);} }while(0)
  for(;t+1<NT;t+=2){
    STEP(pB0,pB1,pA0,pA1,t,(t+3<NT),(t+1<NT),(t+1<NT));       ENDW(t);   RESC(); ROT();
    STEP(pA0,pA1,pB0,pB1,t+1,(t+4<NT),(t+2<NT),(t+2<NT));     ENDW(t+1); RESC(); ROT();
  }
  STEP(pB0,pB1,pA0,pA1,NT-1,false,false,false); RESC();
  { float sacc=pB0[0]+pB0[1]; _Pragma("unroll") for(int r=2;r<16;++r)sacc+=pB0[r]; _Pragma("unroll") for(int r=0;r<16;++r)sacc+=pB1[r]; l_reg+=sacc;
    pw0=(u32x4){PKW(pB0,0),PKW(pB0,2),PKW(pB0,4),PKW(pB0,6)};pw1=(u32x4){PKW(pB0,8),PKW(pB0,10),PKW(pB0,12),PKW(pB0,14)};pw2=(u32x4){PKW(pB1,0),PKW(pB1,2),PKW(pB1,4),PKW(pB1,6)};pw3=(u32x4){PKW(pB1,8),PKW(pB1,10),PKW(pB1,12),PKW(pB1,14)};
    SBAR(); pv(o,vb0+sl_cur,PAF(0),PAF(1),PAF(2),PAF(3)); }
  #undef PKW
  #undef PAF
  #undef VFR
  #undef PIN
  #undef MX3
  #undef GAPA
  #undef GAPB
  #undef EX
  #undef VRD
  #undef KRD
  #undef STEP
  #undef ENDW
  {auto rr=__builtin_amdgcn_permlane32_swap(__float_as_uint(l_reg),__float_as_uint(l_reg),false,false);l_reg=__uint_as_float(rr[0])+__uint_as_float(rr[1]);}
  if(hi==0)wsf[32+r32]=l_reg;asm volatile("s_waitcnt lgkmcnt(0)":::"memory");
  float rli[16];
  #pragma unroll
  for(int r=0;r<16;++r)rli[r]=__builtin_amdgcn_rcpf(wsf[32+crow(r,hi)]);
  bf16*Ow=O+(rowbase+q0+wid*QBLK)*QP+h*D; const bf16*Zw=Z+(rowbase+q0+wid*QBLK)*KP+h*D;
  { bf16*stg=(bf16*)(shm+LDS_OST)+wid*2048;
    #pragma unroll
    for(int r=0;r<16;++r){const int orow=crow(r,hi);
      #pragma unroll
      for(int d0=0;d0<2;++d0)stg[orow*64+d0*32+r32]=__float2bfloat16(o[d0][r]*rli[r]);}
    asm volatile("s_waitcnt lgkmcnt(0)":::"memory");
    #pragma unroll
    for(int i=0;i<4;++i){const int row=i*8+(lane>>3),ch=lane&7; const u32x4 v=*(const u32x4*)(stg+row*64+ch*8); const u32x4 zz=*(const u32x4*)(Zw+(long)row*KP+ch*8); u32x4 w;
      #pragma unroll
      for(int e=0;e<4;++e){const float a0=__uint_as_float(v[e]<<16)*__uint_as_float(zz[e]<<16),a1=__uint_as_float(v[e]&0xffff0000u)*__uint_as_float(zz[e]&0xffff0000u); w[e]=cvtpk_s(a0,a1);}
      if(wr_en)ATTN_STORE16(Ow+(long)row*QP+ch*8,w);} }
  asm volatile("s_waitcnt lgkmcnt(0)\n\ts_barrier":::"memory");
  #undef DMA_K
  #undef DMA_V
  #undef CMASK
  #undef START
  #undef RESC
  #undef ROT
}
constexpr int ATTN_LDS_BYTES=LDS_BYTES;
struct AttnTensors { const bf16* Q; const bf16* K; const bf16* V; const bf16* Z; bf16* O; };
template<int THRL=8> __device__ __forceinline__ void attn_phase(char*lds,const AttnTensors&T,int vcu,int G,bool wr_en){
  for(int U=vcu;U<BATCH*NHEAD*NQB;U+=G){ const int grp=U>>5,loc=U&31; const int b=grp&7,kvh=grp>>3,h=kvh*4+(loc>>3),qb=loc&7;
    attn_unit<THRL>(b,h,kvh,qb,T.Q,T.K,T.V,T.Z,T.O,lds,wr_en); }
}
#undef SBAR
#undef WAIT_BAR
}
constexpr int NWAVES = 8;
constexpr int BATCH = 8, SEQ = 2048, D = 1024, M = BATCH * SEQ, DEPTH = 2;
constexpr int INW = 7936, NMIX = 4864, NGATE = 3072, QUP = 1536, RESTP = 3328;
constexpr float LN_EPS = 1e-5f;
using pg8::LOG2E; using pg8::C2;
constexpr float ALPHA = 1.4142135623730951f;
constexpr size_t MiB = 1u << 20;
constexpr size_t WS_BIASV = 0;
constexpr size_t WS_WIN = 1 * MiB;
constexpr size_t WS_WBR = 32 * MiB;
constexpr size_t WS_WOUT = 38 * MiB;
constexpr size_t WS_SGW = 42 * MiB;
constexpr size_t WS_XN = 44 * MiB;
constexpr size_t WS_QU = 76 * MiB;
constexpr size_t WS_REST = 124 * MiB;
constexpr size_t WS_END = 229 * MiB;
constexpr int RING_OFF = 0;
constexpr int LDS_BYTES = 163840;
constexpr int MISC_OFF = LDS_BYTES - 64;
constexpr size_t WS_BAR = 228 * MiB;

#define GAS __attribute__((address_space(1)))
#define LAS __attribute__((address_space(3)))
typedef unsigned short bf16;
typedef unsigned v4u __attribute__((ext_vector_type(4)));
typedef unsigned v2u __attribute__((ext_vector_type(2)));
typedef float f32x4 __attribute__((ext_vector_type(4)));
typedef short bf16x8 __attribute__((ext_vector_type(8)));
#define LDS_WAIT() asm volatile("s_waitcnt lgkmcnt(0)" ::: "memory")
__device__ __forceinline__ unsigned f2bf(float f) { unsigned u = __builtin_bit_cast(unsigned, f); return (u + 0x7fffu + ((u >> 16) & 1u)) >> 16; }
__device__ __forceinline__ unsigned pk2(float lo, float hi) { return f2bf(lo) | (f2bf(hi) << 16); }
__device__ __forceinline__ float bflo(unsigned w) { return __uint_as_float(w << 16); }
__device__ __forceinline__ float bfhi(unsigned w) { return __uint_as_float(w & 0xffff0000u); }
__device__ __forceinline__ float wave_sum(float v) {
#pragma unroll
    for (int o = 1; o < 64; o <<= 1) v += __shfl_xor(v, o);
    return v;
}
__host__ __device__ __forceinline__ int v2l(int vc) {
    if (vc < 512) return vc;
    if (vc < 1024) return vc - 512 + 2048;
    if (vc < 1536) return vc - 1024 + 3328;
    if (vc < 2048) return vc - 1536 + 512;
    if (vc < 2560) return vc - 2048 + 1024;
    if (vc < 3072) return vc - 2560 + 1536;
    if (vc < 3200) return vc - 3072 + 2560;
    if (vc < 3328) return vc - 3200 + 2688;
    if (vc < 3840) return vc - 3328 + 2816;
    return vc;
}
__device__ __forceinline__ void transpose_item(const float* W, int N, int k0, int n0, bf16* WT, int ldt, int dst_row0, int kofs, LAS float* scr, int lane) {
    float tv[32];
#pragma unroll
    for (int i = 0; i < 32; ++i) tv[i] = __builtin_nontemporal_load(W + (size_t)(k0 + 2 * i + (lane >> 5)) * N + n0 + (lane & 31));
#pragma unroll
    for (int i = 0; i < 32; ++i) scr[(2 * i + (lane >> 5)) * 33 + (lane & 31)] = tv[i];
    LDS_WAIT(); asm volatile("" ::: "memory");
    const int c = lane & 7;
#pragma unroll
    for (int j = 0; j < 4; ++j) { const int n = (lane >> 3) + 8 * j; const LAS float* s = scr + (8 * c) * 33 + n;
        v4u o; o.x = pk2(s[0 * 33], s[1 * 33]); o.y = pk2(s[2 * 33], s[3 * 33]); o.z = pk2(s[4 * 33], s[5 * 33]); o.w = pk2(s[6 * 33], s[7 * 33]);
        *(GAS v4u*)(WT + (size_t)(dst_row0 + n) * ldt + kofs + k0 + 8 * c) = o; }
    LDS_WAIT(); asm volatile("" ::: "memory");
}
template <int NR> __device__ __forceinline__ void ln_rows(const float* xbase, int m0, int stride, int mmax, const float* g, const float* bta, float* obase, bf16* bbase, int lane, bool wr_en = true) {
    f32x4 v[NR][4]; float s[NR];
#pragma unroll
    for (int r = 0; r < NR; ++r) { const int m = min(m0 + r * stride, mmax - 1); const GAS f32x4* xr = (const GAS f32x4*)(xbase + (size_t)m * D) + lane; s[r] = 0.f;
#pragma unroll
        for (int j = 0; j < 4; ++j) v[r][j] = xr[64 * j]; }
#pragma unroll
    for (int r = 0; r < NR; ++r)
#pragma unroll
        for (int j = 0; j < 4; ++j) s[r] += (v[r][j].x + v[r][j].y) + (v[r][j].z + v[r][j].w);
#pragma unroll
    for (int o = 1; o < 64; o <<= 1)
#pragma unroll
        for (int r = 0; r < NR; ++r) s[r] += __shfl_xor(s[r], o);
    float s2[NR];
#pragma unroll
    for (int r = 0; r < NR; ++r) { const float mean = s[r] * (1.f / D); s2[r] = 0.f;
#pragma unroll
        for (int j = 0; j < 4; ++j) { v[r][j] = v[r][j] - mean; s2[r] += (v[r][j].x * v[r][j].x + v[r][j].y * v[r][j].y) + (v[r][j].z * v[r][j].z + v[r][j].w * v[r][j].w); } }
#pragma unroll
    for (int o = 1; o < 64; o <<= 1)
#pragma unroll
        for (int r = 0; r < NR; ++r) s2[r] += __shfl_xor(s2[r], o);
#pragma unroll
    for (int j = 0; j < 4; ++j) { const f32x4 gg = ((const GAS f32x4*)g)[lane + 64 * j], bb = ((const GAS f32x4*)bta)[lane + 64 * j];
#pragma unroll
        for (int r = 0; r < NR; ++r) { const int m = m0 + r * stride; const float rstd = 1.f / sqrtf(s2[r] * (1.f / D) + LN_EPS); const f32x4 y = v[r][j] * rstd * gg + bb;
            if (wr_en && m < mmax) { ((GAS f32x4*)(obase + (size_t)m * D) + lane)[64 * j] = y; v2u w; w.x = pk2(y.x, y.y); w.y = pk2(y.z, y.w); ((GAS v2u*)(bbase + (size_t)m * D) + lane)[64 * j] = w; } } }
}

#define RLX_AGENT __ATOMIC_RELAXED, __HIP_MEMORY_SCOPE_AGENT
#define XB_TMO      128
#define XB_XCNT(j)  (256  + 64 * (j))
#define XB_XSUB(j)  (1280 + 64 * (j))
#define XB_XGEN(j)  (2304 + 64 * (j))
#define XB_TOP      3328
#define XB_TOPGEN   3392
#define XCD_BAR_WORDS 3456
#define XB_SPIN_CAP (1u << 18)

__device__ __forceinline__ unsigned xb_ld(unsigned* p)              { return __hip_atomic_load(p, __ATOMIC_RELAXED, __HIP_MEMORY_SCOPE_AGENT); }
__device__ __forceinline__ unsigned xb_add(unsigned* p, unsigned v) { return __hip_atomic_fetch_add(p, v, __ATOMIC_RELAXED, __HIP_MEMORY_SCOPE_AGENT); }
__device__ __forceinline__ unsigned xb_xcc_id() { return (unsigned)__builtin_amdgcn_s_getreg((3 << 11) | 20) & 0xFu; }
#define XB_SPIN(cond, bar) do { unsigned _sp = 0; while (cond) { __builtin_amdgcn_s_sleep(1); \
    if ((++_sp & 255u) == 0u) { if (xb_ld(&(bar)[XB_TMO])) break; if (_sp > XB_SPIN_CAP) { atomicAdd(&(bar)[XB_TMO], 1u); break; } } } } while (0)

struct XcdBarrier {
    unsigned* bar; unsigned x;
    volatile LAS unsigned* st;
};

__device__ __forceinline__ XcdBarrier xcd_barrier_post(unsigned* bar, volatile LAS unsigned* st) {
    XcdBarrier b; b.bar = bar; b.x = xb_xcc_id(); b.st = st;
    if (threadIdx.x == 0) (void)xb_add(&bar[XB_XCNT(b.x)], 1u);
    return b;
}
__device__ __forceinline__ void xcd_barrier_complete(unsigned* bar, unsigned x, unsigned& nloc, unsigned& nx) {
    const unsigned G = gridDim.x * gridDim.y * gridDim.z;
    unsigned sum, cnt, mine, sp = 0u;
    for (;;) {
        sum = 0u; cnt = 0u; mine = 0u;
#pragma unroll
        for (unsigned j = 0; j < 16; ++j) { const unsigned c = xb_ld(&bar[XB_XCNT(j)]); sum += c; cnt += (c > 0u) ? 1u : 0u; mine = (j == x) ? c : mine; }
        if (sum == G) break;
        __builtin_amdgcn_s_sleep(1);
        if ((++sp & 255u) == 0u) { if (xb_ld(&bar[XB_TMO])) break; if (sp > XB_SPIN_CAP) { atomicAdd(&bar[XB_TMO], 1u); break; } }
    }
    nloc = mine > 0u ? mine : 1u; nx = cnt > 0u ? cnt : 1u;
}

__device__ __forceinline__ void xcd_barrier(const XcdBarrier& b) {
    asm volatile("s_waitcnt vmcnt(0)" ::: "memory");
    __syncthreads();
    if (threadIdx.x == 0) {
        unsigned* bar = b.bar;
        __builtin_amdgcn_s_waitcnt(0);
        unsigned nloc = b.st[0], nx = b.st[1];
        if (nloc == 0u) { xcd_barrier_complete(bar, b.x, nloc, nx); b.st[0] = nloc; b.st[1] = nx; }
        const unsigned old = xb_add(&bar[XB_XSUB(b.x)], 1u);
        const unsigned gen = old / nloc;
        if (old + 1u == (gen + 1u) * nloc) {
            __builtin_amdgcn_fence(__ATOMIC_RELEASE, "agent");
            asm volatile("s_waitcnt vmcnt(0)" ::: "memory");
            const unsigned og = xb_add(&bar[XB_TOP], 1u);
            const unsigned tg = og / nx;
            if (og + 1u == (tg + 1u) * nx) xb_add(&bar[XB_TOPGEN], 1u);
            else XB_SPIN(xb_ld(&bar[XB_TOPGEN]) == tg, bar);
            __builtin_amdgcn_fence(__ATOMIC_ACQUIRE, "agent");
            xb_add(&bar[XB_XGEN(b.x)], 1u);
            asm volatile("s_waitcnt vmcnt(0)" ::: "memory");
        } else {
            XB_SPIN(xb_ld(&bar[XB_XGEN(b.x)]) == gen, bar);
            __builtin_amdgcn_fence(__ATOMIC_ACQUIRE, "agent");
            asm volatile("s_waitcnt vmcnt(0)" ::: "memory");
        }
    }
    __syncthreads();
}

constexpr int NA_K = 0, NA_V = 65536, NA_MS = 131072, NA_ML = NA_MS + 4 * 16 * 68 * 4, NA_RP = NA_ML + 8 * 32 * 4, NA_YT = NA_RP + 480 * 4, NA_END = NA_YT + 64 * 144;
static_assert(NA_END <= LDS_BYTES, "NA LDS map");
__device__ __forceinline__ void na_stage_write(LAS unsigned char* lds, int slot, int key, int dc, v4u kv, v4u vv) {
    *(LAS v4u*)(lds + NA_K + slot * 8192 + key * 128 + ((dc ^ (key & 7)) << 4)) = kv;
    LAS unsigned char* vb = lds + NA_V + slot * 8192 + (dc * 8) * 128 + (key & 7) * 2; const int kc = key >> 3;
#pragma unroll
    for (int e = 0; e < 4; ++e) {
        *(LAS unsigned short*)(vb + (2 * e) * 128 + ((kc ^ (2 * e)) << 4)) = (unsigned short)(vv[e] & 0xffffu);
        *(LAS unsigned short*)(vb + (2 * e + 1) * 128 + ((kc ^ (2 * e + 1)) << 4)) = (unsigned short)(vv[e] >> 16); }
}
__device__ __forceinline__ void na_unit(LAS unsigned char* lds, int b, int h, int oct, bf16* QU, const bf16* REST, const float* rpb, bool wr_en) {
    int tid_ = threadIdx.x; asm volatile("" : "+v"(tid_)); const int tid = tid_, lane = tid & 63, wid = __builtin_amdgcn_readfirstlane(tid >> 6), fr = lane & 15, fq = lane >> 4;
    const int qb = wid & 3, kh = wid >> 2, c0 = 16 * qb, w0 = min(max(16 * qb - 8, 0), 32);
    bf16* Qb = QU + (size_t)b * SEQ * QUP + h * 64;
    const bf16* Kb = REST + (size_t)b * SEQ * RESTP + h * 64; const bf16* Vb = Kb + 512; const bf16* Zb = Kb + 1024;
    LAS float* RP = (LAS float*)(lds + NA_RP); LAS float* ML = (LAS float*)(lds + NA_ML); LAS float* MS = (LAS float*)(lds + NA_MS);
    LAS unsigned char* YT = lds + NA_YT;
    if (tid < 465) RP[tid] = rpb[h * 465 + tid] * LOG2E;
    const int skey = tid >> 3, sdc = tid & 7;
    int rs = min(max(8 * oct - 4, 0), 24);
#pragma unroll
    for (int half = 0; half < 2; ++half) { v4u kv[4], vv[4];
#pragma unroll
        for (int j = 0; j < 4; ++j) { const int kr = rs + half * 4 + j; const size_t off = (size_t)(kr * 64 + skey) * RESTP + sdc * 8; kv[j] = *(const v4u*)(Kb + off); vv[j] = *(const v4u*)(Vb + off); }
#pragma unroll
        for (int j = 0; j < 4; ++j) { const int kr = rs + half * 4 + j; na_stage_write(lds, kr & 7, skey, sdc, kv[j], vv[j]); } }
    bf16x8 q0, q1;
    { const bf16* qp = Qb + (size_t)((8 * oct) * 64 + c0 + fr) * QUP + fq * 8; q0 = *(const bf16x8*)qp; q1 = *(const bf16x8*)(qp + 32); }
    __syncthreads();
    for (int i = 0; i < 8; ++i) {
        const int r = 8 * oct + i;
        const int rs_next = (i < 7) ? min(max(r + 1 - 4, 0), 24) : rs; const bool adv = rs_next > rs;
        v4u pk = (v4u){0u, 0u, 0u, 0u}, pv = pk;
        if (adv) { const size_t off = (size_t)((rs_next + 7) * 64 + skey) * RESTP + sdc * 8; pk = *(const v4u*)(Kb + off); pv = *(const v4u*)(Vb + off); }
        bf16x8 nq0 = q0, nq1 = q1;
        if (i < 7) { const bf16* qp = Qb + (size_t)((r + 1) * 64 + c0 + fr) * QUP + fq * 8; nq0 = *(const bf16x8*)qp; nq1 = *(const bf16x8*)(qp + 32); }
        const v4u zv = *(const v4u*)(Zb + (size_t)(r * 64 + skey) * RESTP + sdc * 8);
        const int c = c0 + fr, cs = min(max(c - 8, 0), 48);
        float sc[4][8]; float mx = -1e30f;
        const int keya = w0 + 8 * (fr >> 2) + (fr & 3);
#pragma unroll
        for (int jr = 0; jr < 4; ++jr) { const int kr = rs + kh * 4 + jr, slot = kr & 7;
            const LAS unsigned char* kb = lds + NA_K + slot * 8192;
            const int ka = keya, kbk = keya + 4;
            const bf16x8 a0 = *(const LAS bf16x8*)(kb + ka * 128 + ((fq ^ (ka & 7)) << 4)), a1 = *(const LAS bf16x8*)(kb + ka * 128 + (((4 + fq) ^ (ka & 7)) << 4));
            const bf16x8 b0 = *(const LAS bf16x8*)(kb + kbk * 128 + ((fq ^ (kbk & 7)) << 4)), b1 = *(const LAS bf16x8*)(kb + kbk * 128 + (((4 + fq) ^ (kbk & 7)) << 4));
            f32x4 sa = (f32x4){0.f, 0.f, 0.f, 0.f}, sb = sa;
            sa = __builtin_amdgcn_mfma_f32_16x16x32_bf16(a0, q0, sa, 0, 0, 0); sa = __builtin_amdgcn_mfma_f32_16x16x32_bf16(a1, q1, sa, 0, 0, 0);
            sb = __builtin_amdgcn_mfma_f32_16x16x32_bf16(b0, q0, sb, 0, 0, 0); sb = __builtin_amdgcn_mfma_f32_16x16x32_bf16(b1, q1, sb, 0, 0, 0);
            const LAS float* rprow = RP + (kr - r + 7) * 31 + 15 - c;
#pragma unroll
            for (int jj = 0; jj < 8; ++jj) { const int k = w0 + 8 * fq + jj; const bool ok = (k >= cs) && (k < cs + 16);
                const float s = (jj < 4 ? sa[jj] : sb[jj - 4]) + (ok ? rprow[k] : 0.f);
                sc[jr][jj] = ok ? s : -1e30f; mx = fmaxf(mx, sc[jr][jj]); } }
        mx = fmaxf(mx, __shfl_xor(mx, 16)); mx = fmaxf(mx, __shfl_xor(mx, 32));
        float ls = 0.f; bf16x8 pa[4];
#pragma unroll
        for (int jr = 0; jr < 4; ++jr) { float p[8];
#pragma unroll
            for (int jj = 0; jj < 8; ++jj) { p[jj] = __builtin_amdgcn_exp2f(sc[jr][jj] - mx); ls += p[jj]; }
            v4u w; w.x = pk2(p[0], p[1]); w.y = pk2(p[2], p[3]); w.z = pk2(p[4], p[5]); w.w = pk2(p[6], p[7]); pa[jr] = __builtin_bit_cast(bf16x8, w); }
        ls += __shfl_xor(ls, 16); ls += __shfl_xor(ls, 32);
        f32x4 o[4];
#pragma unroll
        for (int db = 0; db < 4; ++db) { o[db] = (f32x4){0.f, 0.f, 0.f, 0.f}; const int d = 16 * db + fr;
#pragma unroll
            for (int jr = 0; jr < 4; ++jr) { const int slot = (rs + kh * 4 + jr) & 7;
                const bf16x8 vb = *(const LAS bf16x8*)(lds + NA_V + slot * 8192 + d * 128 + ((((w0 >> 3) + fq) ^ (d & 7)) << 4));
                o[db] = __builtin_amdgcn_mfma_f32_16x16x32_bf16(pa[jr], vb, o[db], 0, 0, 0); } }
        if (fq == 0) { ML[wid * 32 + fr] = mx; ML[wid * 32 + 16 + fr] = ls; }
        if (kh == 1) {
#pragma unroll
            for (int db = 0; db < 4; ++db)
#pragma unroll
                for (int j = 0; j < 4; ++j) MS[(qb * 16 + 4 * fq + j) * 68 + 16 * db + fr] = o[db][j]; }
        __syncthreads();
        if (adv) na_stage_write(lds, (rs_next + 7) & 7, skey, sdc, pk, pv);
        if (kh == 0) {
#pragma unroll
            for (int j = 0; j < 4; ++j) { const int q = 4 * fq + j;
                const float m0 = ML[wid * 32 + q], l0 = ML[wid * 32 + 16 + q], m1 = ML[(wid + 4) * 32 + q], l1 = ML[(wid + 4) * 32 + 16 + q];
                const float mt = fmaxf(m0, m1), a0 = __builtin_amdgcn_exp2f(m0 - mt), a1 = __builtin_amdgcn_exp2f(m1 - mt), inv = 1.0f / (l0 * a0 + l1 * a1);
#pragma unroll
                for (int db = 0; db < 4; ++db) { const int d = 16 * db + fr;
                    const float ov = (o[db][j] * a0 + MS[(qb * 16 + q) * 68 + d] * a1) * inv;
                    *(LAS unsigned short*)(YT + (c0 + q) * 144 + d * 2) = (unsigned short)f2bf(ov); } } }
        __syncthreads();
        { const v4u yv = *(const LAS v4u*)(YT + skey * 144 + sdc * 16); v4u w;
#pragma unroll
            for (int e = 0; e < 4; ++e) w[e] = pk2(bflo(yv[e]) * bflo(zv[e]), bfhi(yv[e]) * bfhi(zv[e]));
            if (wr_en) *(v4u*)(Qb + (size_t)(r * 64 + skey) * QUP + sdc * 8) = w; }
        rs = rs_next; q0 = nq0; q1 = nq1;
    }
    __syncthreads();
}

__device__ __forceinline__ void sg_unit(LAS unsigned char* lds, int b, int chunk, int gh, bf16* QU, const bf16* REST, const float* lng, const float* lnb, const bf16* sgw, const float* sgb, bool wr_en) {
    int tid_ = threadIdx.x; asm volatile("" : "+v"(tid_)); const int tid = tid_, lane = tid & 63, wid = __builtin_amdgcn_readfirstlane(tid >> 6), fr = lane & 15, fq = lane >> 4;
    const size_t tok0 = (size_t)b * SEQ + chunk * 128;
    const bf16* Vp = REST + tok0 * RESTP + 2304; const bf16* Zp = REST + tok0 * RESTP + 2816; bf16* Up = QU + tok0 * QUP + 1024;
    {
        const f32x4 g0 = *(const f32x4*)(lng + lane * 8), g1 = *(const f32x4*)(lng + lane * 8 + 4), b0 = *(const f32x4*)(lnb + lane * 8), b1 = *(const f32x4*)(lnb + lane * 8 + 4);
        const bool mine = (lane >> 5) == gh; const int cl0 = (lane & 31) * 8;
        v4u raw[16];
#pragma unroll
        for (int i = 0; i < 16; ++i) raw[i] = *(const v4u*)(Vp + (size_t)(wid * 16 + i) * RESTP + lane * 8);
#pragma unroll
        for (int bt = 0; bt < 4; ++bt) { float x[4][8], s[4], s2[4];
#pragma unroll
            for (int t = 0; t < 4; ++t) { s[t] = 0.f; s2[t] = 0.f;
#pragma unroll
                for (int e = 0; e < 4; ++e) { x[t][2 * e] = bflo(raw[4 * bt + t][e]); x[t][2 * e + 1] = bfhi(raw[4 * bt + t][e]); }
#pragma unroll
                for (int e = 0; e < 8; ++e) { s[t] += x[t][e]; s2[t] += x[t][e] * x[t][e]; } }
#pragma unroll
            for (int o = 1; o < 64; o <<= 1)
#pragma unroll
                for (int t = 0; t < 4; ++t) { s[t] += __shfl_xor(s[t], o); s2[t] += __shfl_xor(s2[t], o); }
            float mean[4], rstd[4];
#pragma unroll
            for (int t = 0; t < 4; ++t) { mean[t] = s[t] * (1.0f / 512.0f); rstd[t] = 1.f / sqrtf(fmaxf(s2[t] * (1.0f / 512.0f) - mean[t] * mean[t], 0.f) + LN_EPS); }
            if (mine) { const int n0 = wid * 16 + 4 * bt;
#pragma unroll
                for (int e = 0; e < 8; ++e) { const float ge = (e < 4 ? g0[e & 3] : g1[e & 3]), be = (e < 4 ? b0[e & 3] : b1[e & 3]); const int cl = cl0 + e;
                    v2u w; w.x = pk2((x[0][e] - mean[0]) * rstd[0] * ge + be, (x[1][e] - mean[1]) * rstd[1] * ge + be); w.y = pk2((x[2][e] - mean[2]) * rstd[2] * ge + be, (x[3][e] - mean[3]) * rstd[3] * ge + be);
                    *(LAS v2u*)(lds + cl * 256 + (((n0 >> 3) ^ (cl & 15)) << 4) + (n0 & 7) * 2) = w; } }
        }
    }
    __syncthreads();
    {
        const int gl = wid & 3, g = 4 * gh + gl, mh = wid >> 2;
        const bf16* Wg = sgw + (size_t)g * 128 * 128;
        f32x4 acc[4][4];
#pragma unroll
        for (int db = 0; db < 4; ++db)
#pragma unroll
            for (int mb = 0; mb < 4; ++mb) acc[db][mb] = (f32x4){0.f, 0.f, 0.f, 0.f};
#pragma unroll
        for (int ks = 0; ks < 4; ++ks) { bf16x8 af[4], bfr[4];
#pragma unroll
            for (int db = 0; db < 4; ++db) { const int cl = gl * 64 + 16 * db + fr; af[db] = *(const LAS bf16x8*)(lds + cl * 256 + (((ks * 4 + fq) ^ (cl & 15)) << 4)); }
#pragma unroll
            for (int mb = 0; mb < 4; ++mb) bfr[mb] = *(const bf16x8*)(Wg + (size_t)(64 * mh + 16 * mb + fr) * 128 + ks * 32 + fq * 8);
#pragma unroll
            for (int db = 0; db < 4; ++db)
#pragma unroll
                for (int mb = 0; mb < 4; ++mb) acc[db][mb] = __builtin_amdgcn_mfma_f32_16x16x32_bf16(af[db], bfr[mb], acc[db][mb], 0, 0, 0); }
#pragma unroll
        for (int mb = 0; mb < 4; ++mb) { const int m = 64 * mh + 16 * mb + fr; const float bs = sgb[g * 128 + m];
            v2u uu[4], zz[4];
#pragma unroll
            for (int db = 0; db < 4; ++db) { const int c = 64 * g + 16 * db + 4 * fq; uu[db] = *(const v2u*)(Up + (size_t)m * QUP + c); zz[db] = *(const v2u*)(Zp + (size_t)m * RESTP + c); }
#pragma unroll
            for (int db = 0; db < 4; ++db) { const int c = 64 * g + 16 * db + 4 * fq; const f32x4 a = acc[db][mb];
                v2u w; w.x = pk2(bflo(uu[db].x) * (a[0] + bs) * bflo(zz[db].x), bfhi(uu[db].x) * (a[1] + bs) * bfhi(zz[db].x)); w.y = pk2(bflo(uu[db].y) * (a[2] + bs) * bflo(zz[db].y), bfhi(uu[db].y) * (a[3] + bs) * bfhi(zz[db].y));
                if (wr_en) *(v2u*)(Up + (size_t)m * QUP + c) = w; } }
    }
    __syncthreads();
}
struct Args {
    const float *x, *ln_in_g, *ln_in_b, *w_in, *b_in, *na_rpb, *q_norm_g, *k_norm_g, *sg_ln_g, *sg_ln_b, *sg_w, *sg_b, *w_br_a, *w_br_b, *w_br_c, *w_out, *b_out, *ln_post_g, *ln_post_b;
    float* out; unsigned char* ws; int force; int pad;
};
#ifndef PROBE
#define PROBE 0
#endif
typedef const __attribute__((address_space(4))) Args* KArgs;
__device__ __forceinline__ KArgs kargs() { KArgs p = (KArgs)__builtin_amdgcn_kernarg_segment_ptr(); asm volatile("" : "+s"(p)); return p; }
#define WSP(off) ((unsigned char*)kargs()->ws + (off))
__global__ void __launch_bounds__(NWAVES * 64, 2) mega_fwd(Args a_unused) {
    extern __shared__ __attribute__((aligned(16))) unsigned char lds_raw[];
    cg::grid_group grid = cg::this_grid();
    LAS unsigned char* lds = (LAS unsigned char*)lds_raw;
    const int tid = threadIdx.x, lane = tid & 63, wave = __builtin_amdgcn_readfirstlane(tid >> 6);
    const int G = gridDim.x, bx = blockIdx.x; const int vcu = (G % 8 == 0) ? (bx % 8) * (G / 8) + bx / 8 : bx;
    if (tid < 16) ((LAS unsigned*)(lds + MISC_OFF))[tid] = 0u;
    if (bx == 0) { unsigned* barw = (unsigned*)WSP(WS_BAR); for (int i = tid; i < XCD_BAR_WORDS; i += NWAVES * 64) barw[i] = 0u; }
    __syncthreads();
    const int gw = vcu * NWAVES + wave, NGW = G * NWAVES;
#define BIASV ((float*)WSP(WS_BIASV))
#define WIN ((bf16*)WSP(WS_WIN))
#define WBR ((bf16*)WSP(WS_WBR))
#define WOUT ((bf16*)WSP(WS_WOUT))
#define SGW ((bf16*)WSP(WS_SGW))
#define XN ((bf16*)WSP(WS_XN))
#define QU ((bf16*)WSP(WS_QU))
#define REST ((bf16*)WSP(WS_REST))
#define GT REST
#define H (kargs()->out)

#define GRID_BAR() do { XcdBarrier b_; b_.bar = (unsigned*)WSP(WS_BAR); b_.x = xb_xcc_id(); b_.st = (volatile LAS unsigned*)(lds + MISC_OFF); xcd_barrier(b_); } while (0)
#ifndef SKIPMASK
#define SKIPMASK 0
#endif
#define SKIP(b) (SKIPMASK != 0 && pass == 0 && ((SKIPMASK) & (b)))
    { constexpr int pass = 0;
    if (!SKIP(1)) for (int rep = 0; rep < ((PROBE & 64) ? 2 : 1); ++rep) {
        LAS float* scr = (LAS float*)(lds + wave * 16384);
        constexpr int I_IN = 16 * (INW / 32), I_BR = 8 * 32, I_OUT = 16 * 32;
        constexpr int PER_L = I_IN + 3 * I_BR + I_OUT, NITEMS = DEPTH * PER_L;
        for (int it = gw; it < NITEMS; it += NGW) {
            const int l = it / PER_L; int r = it % PER_L;
            if (r < I_IN) { const int kb = r / (INW / 32), pb = r % (INW / 32);
                const int tile = pb >> 3, wblk = pb & 7, bj = wblk >> 2, wc = wblk & 3; const int vc0 = tile * 256 + wc * 64 + bj * 32;
                transpose_item(kargs()->w_in + (size_t)l * D * INW, INW, 64 * kb, v2l(vc0), WIN + (size_t)l * INW * D, D, 32 * pb, 0, scr, lane); continue; }
            r -= I_IN;
            if (r < 3 * I_BR) { const int br = r / I_BR, q = r % I_BR, kb = q / 32, nb = q % 32; const float* W = (br == 0 ? kargs()->w_br_a : br == 1 ? kargs()->w_br_b : kargs()->w_br_c) + (size_t)l * 512 * D;
                transpose_item(W, D, 64 * kb, 32 * nb, WBR + (size_t)l * D * 1536, 1536, 32 * nb, 512 * br, scr, lane); continue; }
            r -= 3 * I_BR;
            { const int kb = r / 32, nb = r % 32; transpose_item(kargs()->w_out + (size_t)l * D * D, D, 64 * kb, 32 * nb, WOUT + (size_t)l * D * D, D, 32 * nb, 0, scr, lane); }
        }
        const int gt = (vcu * NWAVES + wave) * 64 + lane, NGT = NGW * 64;
        for (int i = gt; i < DEPTH * 8 * 128 * 128 / 2; i += NGT) { const float2 v = ((const float2*)kargs()->sg_w)[i]; ((unsigned*)SGW)[i] = pk2(v.x, v.y); }
        for (int i = gt; i < DEPTH * INW; i += NGT) { const int l = i / INW, p = i % INW; BIASV[i] = kargs()->b_in[l * INW + v2l(p)]; }
        for (int m = gw; m < M; m += 4 * NGW) ln_rows<4>(kargs()->x, m, NGW, M, kargs()->ln_in_g, kargs()->ln_in_b, H, XN, lane);
    }
    if (pass > 0) GRID_BAR();
    if (pass == 0) {
    grid.sync();
    (void)xcd_barrier_post((unsigned*)WSP(WS_BAR), (volatile LAS unsigned*)(lds + MISC_OFF));
    }

    { constexpr int l = 0;
#ifndef NO_P1
        if (!SKIP(2)) for (int rep = 0; rep < ((PROBE & 16) ? 2 : 1); ++rep) {
            pg8::Gemm g{XN, WIN + (size_t)l * INW * D, M, NMIX, D, D, D}; pg8::StaticOrder S; S.init(M, NMIX, G, bx);
            pg8::EpiIn E{QU, REST, BIASV + l * INW, kargs()->q_norm_g + l * 64, kargs()->k_norm_g + l * 64};
            pg8::gemm_phase<pg8::EpiIn, pg8::StaticOrder, true, true>(lds + RING_OFF, g, S, E);
        }
#endif
        GRID_BAR();
        {
            const attn_body::AttnTensors AT{(const attn_body::bf16*)(QU + 512), (const attn_body::bf16*)(REST + 1536), (const attn_body::bf16*)(REST + 1664), (const attn_body::bf16*)(REST + 1792), (attn_body::bf16*)(QU + 512)};
#ifndef NO_ATT
            if (!SKIP(4)) for (int rep = 0; rep < ((PROBE & 8) ? 2 : 1); ++rep) { attn_body::attn_phase<8>((char*)lds_raw + RING_OFF, AT, vcu, G, (rep == ((PROBE & 8) ? 1 : 0)) || (kargs()->force != 0)); __syncthreads(); }
#endif
            __syncthreads();
#ifndef NO_NA
            if (!SKIP(8)) for (int rep = 0; rep < ((PROBE & 2) ? 2 : 1); ++rep)
            for (int U = vcu; U < BATCH * 8 * 4; U += G) na_unit(lds, U >> 5, (U >> 2) & 7, U & 3, QU, REST, kargs()->na_rpb + (size_t)l * 8 * 465, (rep == ((PROBE & 2) ? 1 : 0)) || (kargs()->force != 0));
#endif
            __syncthreads();
#ifndef NO_SG
            if (!SKIP(16)) for (int rep = 0; rep < ((PROBE & 4) ? 2 : 1); ++rep)
            for (int U = vcu; U < BATCH * 16 * 2; U += G) sg_unit(lds, U >> 5, (U >> 1) & 15, U & 1, QU, REST, kargs()->sg_ln_g + l * 512, kargs()->sg_ln_b + l * 512, SGW + (size_t)l * 8 * 128 * 128, kargs()->sg_b + l * 8 * 128, (rep == ((PROBE & 4) ? 1 : 0)) || (kargs()->force != 0));
#endif
        }
        GRID_BAR();
#ifndef NO_P1B
        if (!SKIP(32)) for (int rep = 0; rep < ((PROBE & 32) ? 2 : 1); ++rep) {
            pg8::Gemm g{XN, WIN + (size_t)l * INW * D + (size_t)NMIX * D, M, NGATE, D, D, D}; pg8::StaticOrder S; S.init(M, NGATE, G, bx);
            pg8::EpiGate E{GT, BIASV + l * INW + NMIX};
            pg8::gemm_phase<pg8::EpiGate, pg8::StaticOrder, true, true>(lds + RING_OFF, g, S, E);
        }
#endif
        GRID_BAR();
#ifndef NO_P3
        if (!SKIP(64)) for (int rep = 0; rep < ((PROBE & 32) ? 2 : 1); ++rep) {
            pg8::Gemm g{QU, WBR + (size_t)l * D * 1536, M, D, 1536, 1536, 1536}; pg8::StaticOrder S; S.init(M, D, G, bx);
            pg8::EpiMerge E{GT, XN};
            pg8::gemm_phase<pg8::EpiMerge, pg8::StaticOrder, true, true>(lds + RING_OFF, g, S, E);
        }
#endif
        GRID_BAR();
#ifndef NO_P4
        if (!SKIP(128)) for (int rep = 0; rep < ((PROBE & 128) ? 2 : 1); ++rep) {
            pg8::Gemm g{XN, WOUT + (size_t)l * D * D, M, D, D, D, D}; pg8::StaticOrder S; S.init(M, D, G, bx);
            pg8::EpiOut E{H, kargs()->b_out + l * D, ALPHA, (rep == ((PROBE & 128) ? 1 : 0)) || (kargs()->force != 0)};
            pg8::gemm_phase<pg8::EpiOut, pg8::StaticOrder, true, true>(lds + RING_OFF, g, S, E);
        }
#endif
        GRID_BAR();
        if (!SKIP(256)) for (int rep = 0; rep < ((PROBE & 256) ? 2 : 1); ++rep)
        for (int m = gw; m < M; m += 4 * NGW) ln_rows<4>(H, m, NGW, M, kargs()->ln_post_g + l * D, kargs()->ln_post_b + l * D, H, XN, lane, (rep == ((PROBE & 256) ? 1 : 0)) || (kargs()->force != 0));
        if (l + 1 < DEPTH) GRID_BAR();
        if (PROBE & 1) { for (int i = 0; i < 6; ++i) GRID_BAR(); }
    }
    { constexpr int l = 1;
#ifndef NO_P1
        if (!SKIP(2)) for (int rep = 0; rep < ((PROBE & 16) ? 2 : 1); ++rep) {
            pg8::Gemm g{XN, WIN + (size_t)l * INW * D, M, NMIX, D, D, D}; pg8::StaticOrder S; S.init(M, NMIX, G, bx);
            pg8::EpiIn E{QU, REST, BIASV + l * INW, kargs()->q_norm_g + l * 64, kargs()->k_norm_g + l * 64};
            pg8::gemm_phase<pg8::EpiIn, pg8::StaticOrder, true, true>(lds + RING_OFF, g, S, E);
        }
#endif
        GRID_BAR();
        {
            const attn_body::AttnTensors AT{(const attn_body::bf16*)(QU + 512), (const attn_body::bf16*)(REST + 1536), (const attn_body::bf16*)(REST + 1664), (const attn_body::bf16*)(REST + 1792), (attn_body::bf16*)(QU + 512)};
#ifndef NO_ATT
            if (!SKIP(4)) for (int rep = 0; rep < ((PROBE & 8) ? 2 : 1); ++rep) { attn_body::attn_phase<8>((char*)lds_raw + RING_OFF, AT, vcu, G, (rep == ((PROBE & 8) ? 1 : 0)) || (kargs()->force != 0)); __syncthreads(); }
#endif
            __syncthreads();
#ifndef NO_NA
            if (!SKIP(8)) for (int rep = 0; rep < ((PROBE & 2) ? 2 : 1); ++rep)
            for (int U = vcu; U < BATCH * 8 * 4; U += G) na_unit(lds, U >> 5, (U >> 2) & 7, U & 3, QU, REST, kargs()->na_rpb + (size_t)l * 8 * 465, (rep == ((PROBE & 2) ? 1 : 0)) || (kargs()->force != 0));
#endif
            __syncthreads();
#ifndef NO_SG
            if (!SKIP(16)) for (int rep = 0; rep < ((PROBE & 4) ? 2 : 1); ++rep)
            for (int U = vcu; U < BATCH * 16 * 2; U += G) sg_unit(lds, U >> 5, (U >> 1) & 15, U & 1, QU, REST, kargs()->sg_ln_g + l * 512, kargs()->sg_ln_b + l * 512, SGW + (size_t)l * 8 * 128 * 128, kargs()->sg_b + l * 8 * 128, (rep == ((PROBE & 4) ? 1 : 0)) || (kargs()->force != 0));
#endif
        }
        GRID_BAR();
#ifndef NO_P1B
        if (!SKIP(32)) for (int rep = 0; rep < ((PROBE & 32) ? 2 : 1); ++rep) {
            pg8::Gemm g{XN, WIN + (size_t)l * INW * D + (size_t)NMIX * D, M, NGATE, D, D, D}; pg8::StaticOrder S; S.init(M, NGATE, G, bx);
            pg8::EpiGate E{GT, BIASV + l * INW + NMIX};
            pg8::gemm_phase<pg8::EpiGate, pg8::StaticOrder, true, true>(lds + RING_OFF, g, S, E);
        }
#endif
        GRID_BAR();
#ifndef NO_P3
        if (!SKIP(64)) for (int rep = 0; rep < ((PROBE & 32) ? 2 : 1); ++rep) {
            pg8::Gemm g{QU, WBR + (size_t)l * D * 1536, M, D, 1536, 1536, 1536}; pg8::StaticOrder S; S.init(M, D, G, bx);
            pg8::EpiMerge E{GT, XN};
            pg8::gemm_phase<pg8::EpiMerge, pg8::StaticOrder, true, true>(lds + RING_OFF, g, S, E);
        }
#endif
        GRID_BAR();
#ifndef NO_P4
        if (!SKIP(128)) for (int rep = 0; rep < ((PROBE & 128) ? 2 : 1); ++rep) {
            pg8::Gemm g{XN, WOUT + (size_t)l * D * D, M, D, D, D, D}; pg8::StaticOrder S; S.init(M, D, G, bx);
            pg8::EpiOut E{H, kargs()->b_out + l * D, ALPHA, (rep == ((PROBE & 128) ? 1 : 0)) || (kargs()->force != 0)};
            pg8::gemm_phase<pg8::EpiOut, pg8::StaticOrder, true, true>(lds + RING_OFF, g, S, E);
        }
#endif
        GRID_BAR();
        if (!SKIP(256)) for (int rep = 0; rep < ((PROBE & 256) ? 2 : 1); ++rep)
        for (int m = gw; m < M; m += 4 * NGW) ln_rows<4>(H, m, NGW, M, kargs()->ln_post_g + l * D, kargs()->ln_post_b + l * D, H, XN, lane, (rep == ((PROBE & 256) ? 1 : 0)) || (kargs()->force != 0));
        if (l + 1 < DEPTH) GRID_BAR();
        if (PROBE & 1) { for (int i = 0; i < 6; ++i) GRID_BAR(); }
    }
    }
}

extern "C" void kernel_launch(void* const* d_in, const int* in_sizes, int n_in, void* d_out, int out_size, void* d_ws, size_t ws_size, hipStream_t stream) {
    static int grid = 0;
    if (grid == 0) {
        if (n_in != 19 || in_sizes[0] != M * D || out_size != M * D || ws_size < WS_END) { fprintf(stderr, "kernel_launch: unexpected shapes (n_in %d, in0 %d, out %d, ws %zu); nothing launched\n", n_in, n_in > 0 ? in_sizes[0] : -1, out_size, ws_size); grid = -1; return; }
        int dev = 0, cus = 0, per_cu = 0;
        if (hipGetDevice(&dev) != hipSuccess || hipDeviceGetAttribute(&cus, hipDeviceAttributeMultiprocessorCount, dev) != hipSuccess) { grid = -1; return; }
        if (hipFuncSetAttribute((const void*)mega_fwd, hipFuncAttributeMaxDynamicSharedMemorySize, LDS_BYTES) != hipSuccess) { fprintf(stderr, "kernel_launch: hipFuncSetAttribute failed\n"); grid = -1; return; }
        if (hipOccupancyMaxActiveBlocksPerMultiprocessor(&per_cu, (const void*)mega_fwd, NWAVES * 64, LDS_BYTES) != hipSuccess || per_cu < 1) { fprintf(stderr, "kernel_launch: occupancy query reports %d\n", per_cu); per_cu = 1; }
        (void)hipGetLastError();
        grid = cus * per_cu;
    }
    if (grid < 0) return;
    Args a{};
    const float** f = (const float**)&a;
    for (int i = 0; i < 19; ++i) f[i] = (const float*)d_in[i];
    a.out = (float*)d_out; a.ws = (unsigned char*)d_ws;
    void* args[] = {&a};
    const hipError_t e = hipLaunchCooperativeKernel((const void*)mega_fwd, dim3(grid), dim3(NWAVES * 64), args, LDS_BYTES, stream);
    if (e != hipSuccess) fprintf(stderr, "kernel_launch: cooperative launch failed: %s (grid %d)\n", hipGetErrorString(e), grid);
}
```
